# Optimizing an MI355X kernel written in HIP

```python
import jax, jax.numpy as jnp
from jax import lax
import numpy as np

D_MODEL = 1024
BATCH = 4
SEQ = 4096
DEPTH = 2

MIX_WIDTH = D_MODEL
GROUP_WIDTH = MIX_WIDTH // 4
ROPE_THETA = 500000.0
NORM_EPS = 1e-6

MLA_HEADS = 4
MLA_V = GROUP_WIDTH // MLA_HEADS
MLA_NOPE = 64
MLA_ROPE = 32
MLA_Q_RANK = D_MODEL // 4
MLA_KV_RANK = D_MODEL // 8
MLA_Q_BLOCK = 128

GLA_HEADS = 4
GLA_DV = GROUP_WIDTH // GLA_HEADS
GLA_DK = GLA_DV // 2
GLA_GATE_RANK = 16
GLA_TAU = 16.0
GLA_CHUNK = 64

MOBA_HEADS = 4
MOBA_HD = GROUP_WIDTH // MOBA_HEADS
MOBA_ROT = MOBA_HD // 4
MOBA_BLOCK = 256
MOBA_TOPK = 3
MOBA_Q_CHUNK = 64

LRU_WIDTH = GROUP_WIDTH
LRU_BLOCKS = 4
LRU_BW = LRU_WIDTH // LRU_BLOCKS
LRU_CONV = 4
LRU_C = 8.0

FFN_HIDDEN = -(-8 * D_MODEL // (3 * 256)) * 256

IN_SPLITS = (
    MLA_Q_RANK, MLA_KV_RANK, MLA_ROPE,
    GLA_HEADS * GLA_DK, GLA_HEADS * GLA_DK, GROUP_WIDTH, GLA_GATE_RANK, GROUP_WIDTH,
    GROUP_WIDTH, GROUP_WIDTH, GROUP_WIDTH,
    LRU_WIDTH, LRU_WIDTH,
)
IN_WIDTH = int(sum(IN_SPLITS))
SPLIT_POINTS = [int(s) for s in np.cumsum(IN_SPLITS)[:-1]]

kernel_name = "hybrid_parallel_mla_gla_moba_rglru"


def rms_norm(x, g):
    xf = x.astype(jnp.float32)
    y = xf * lax.rsqrt(jnp.mean(xf * xf, axis=-1, keepdims=True) + NORM_EPS)
    return (y * g.astype(jnp.float32)).astype(x.dtype)


def rope_tables(seq_len, dim):
    inv_freq = ROPE_THETA ** (-jnp.arange(0, dim, 2, dtype=jnp.float32) / dim)
    ang = jnp.arange(seq_len, dtype=jnp.float32)[:, None] * inv_freq[None, :]
    return jnp.cos(ang), jnp.sin(ang)


def apply_rope(x, cos, sin):
    half = x.shape[-1] // 2
    x1 = x[..., :half].astype(jnp.float32)
    x2 = x[..., half:].astype(jnp.float32)
    return jnp.concatenate([x1 * cos - x2 * sin, x2 * cos + x1 * sin], axis=-1).astype(x.dtype)


def causal_attention(q, k, v, scale):
    B, H, S, _ = q.shape
    dv = v.shape[-1]
    kpos = jnp.arange(S)

    def one(i):
        start = i * MLA_Q_BLOCK
        qb = lax.dynamic_slice_in_dim(q, start, MLA_Q_BLOCK, axis=2)
        s = jnp.einsum('bhqd,bhkd->bhqk', qb, k).astype(jnp.float32) * scale
        qpos = start + jnp.arange(MLA_Q_BLOCK)
        s = jnp.where(kpos[None, :] <= qpos[:, None], s, -jnp.inf)
        p = jax.nn.softmax(s, axis=-1).astype(v.dtype)
        return jnp.einsum('bhqk,bhkd->bhqd', p, v)

    o = lax.map(one, jnp.arange(S // MLA_Q_BLOCK))
    return jnp.moveaxis(o, 0, 2).reshape(B, H, S, dv)


def mla_mixer(c_q, c_kv, k_pe, q_norm_g, w_uq, kv_norm_g, w_ukv, cos, sin):
    B, S, _ = c_q.shape
    q = (rms_norm(c_q, q_norm_g) @ w_uq).reshape(B, S, MLA_HEADS, MLA_NOPE + MLA_ROPE).transpose(0, 2, 1, 3)
    q = jnp.concatenate([q[..., :MLA_NOPE], apply_rope(q[..., MLA_NOPE:], cos, sin)], axis=-1)
    kv = (rms_norm(c_kv, kv_norm_g) @ w_ukv).reshape(B, S, MLA_HEADS, MLA_NOPE + MLA_V).transpose(0, 2, 1, 3)
    k_pe = apply_rope(k_pe[:, None], cos, sin)
    k = jnp.concatenate([kv[..., :MLA_NOPE], jnp.broadcast_to(k_pe, (B, MLA_HEADS, S, MLA_ROPE))], axis=-1)
    v = kv[..., MLA_NOPE:]
    o = causal_attention(q, k, v, (MLA_NOPE + MLA_ROPE) ** -0.5)
    return o.transpose(0, 2, 1, 3).reshape(B, S, MLA_HEADS * MLA_V)


def gla_mixer(q, k, v, a_low, g, w_a2, b_a2, head_norm_g):
    B, S, _ = q.shape
    H, C = GLA_HEADS, GLA_CHUNK
    N = S // C

    def heads(t, d):
        return t.reshape(B, S, H, d).transpose(0, 2, 1, 3).reshape(B, H, N, C, d).astype(jnp.float32)

    log_a = jax.nn.log_sigmoid((a_low @ w_a2 + b_a2).astype(jnp.float32)) / GLA_TAU
    qf = heads(q, GLA_DK) * GLA_DK ** -0.5
    kf = heads(k, GLA_DK)
    vf = heads(v, GLA_DV)
    b = jnp.cumsum(heads(log_a, GLA_DK), axis=3)
    b_last = b[:, :, :, -1:, :]
    b_ref = 0.5 * b_last
    att = jnp.einsum('bhncd,bhnsd->bhncs', qf * jnp.exp(b - b_ref), kf * jnp.exp(b_ref - b))
    causal = jnp.tril(jnp.ones((C, C), dtype=bool))
    o_intra = jnp.einsum('bhncs,bhnsv->bhncv', jnp.where(causal, att, 0.0), vf)
    d_state = jnp.einsum('bhncd,bhncv->bhndv', kf * jnp.exp(b_last - b), vf)
    decay = jnp.exp(b_last[:, :, :, 0, :])

    def step(state, inp):
        dcy, ds = inp
        return dcy[..., None] * state + ds, state

    _, s_before = lax.scan(step, jnp.zeros((B, H, GLA_DK, GLA_DV), jnp.float32),
                           (jnp.moveaxis(decay, 2, 0), jnp.moveaxis(d_state, 2, 0)))
    s_before = jnp.moveaxis(s_before, 0, 2)
    o_inter = jnp.einsum('bhncd,bhndv->bhncv', qf * jnp.exp(b), s_before)
    o = (o_intra + o_inter).reshape(B, H, S, GLA_DV)
    o = rms_norm(o, head_norm_g).transpose(0, 2, 1, 3).reshape(B, S, H * GLA_DV)
    return (o * jax.nn.silu(g.astype(jnp.float32))).astype(g.dtype)


def moba_mixer(q, k, v, cos, sin):
    B, S, _ = q.shape
    H, D, BS, QC = MOBA_HEADS, MOBA_HD, MOBA_BLOCK, MOBA_Q_CHUNK

    def heads(t):
        return t.reshape(B, S, H, D).transpose(0, 2, 1, 3)

    def partial_rope(t):
        return jnp.concatenate([apply_rope(t[..., :MOBA_ROT], cos, sin), t[..., MOBA_ROT:]], axis=-1)

    q = partial_rope(heads(q))
    k = partial_rope(heads(k))
    v = heads(v)
    pad = (-S) % BS
    Sp = S + pad
    padw = ((0, 0), (0, 0), (0, pad), (0, 0))
    q, k, v = jnp.pad(q, padw), jnp.pad(k, padw), jnp.pad(v, padw)
    NB = Sp // BS
    topk = min(MOBA_TOPK, NB)
    k_blocks = k.reshape(B, H, NB, BS, D)
    v_blocks = v.reshape(B, H, NB, BS, D)
    k_mean = jnp.mean(k_blocks.astype(jnp.float32), axis=3)
    scale = D ** -0.5
    bi = jnp.arange(B)[:, None, None, None]
    hi = jnp.arange(H)[None, :, None, None]

    def one(i):
        start = i * QC
        blk = start // BS
        qb = lax.dynamic_slice_in_dim(q, start, QC, axis=2)
        gate = jnp.einsum('bhqd,bhnd->bhqn', qb.astype(jnp.float32), k_mean)
        gate = jnp.where(jnp.arange(NB) < blk, gate, -jnp.inf)
        _, idx = lax.top_k(gate, topk)
        valid = idx < blk
        k_sel = k_blocks[bi, hi, idx]
        v_sel = v_blocks[bi, hi, idx]
        s_sel = jnp.einsum('bhqd,bhqjkd->bhqjk', qb, k_sel).astype(jnp.float32) * scale
        s_sel = jnp.where(valid[..., None], s_sel, -jnp.inf).reshape(B, H, QC, topk * BS)
        k_own = lax.dynamic_slice_in_dim(k, blk * BS, BS, axis=2)
        v_own = lax.dynamic_slice_in_dim(v, blk * BS, BS, axis=2)
        s_own = jnp.einsum('bhqd,bhkd->bhqk', qb, k_own).astype(jnp.float32) * scale
        causal = (blk * BS + jnp.arange(BS))[None, :] <= (start + jnp.arange(QC))[:, None]
        s_own = jnp.where(causal, s_own, -jnp.inf)
        p = jax.nn.softmax(jnp.concatenate([s_own, s_sel], axis=-1), axis=-1).astype(v.dtype)
        p_own = p[..., :BS]
        p_sel = p[..., BS:].reshape(B, H, QC, topk, BS)
        return (jnp.einsum('bhqk,bhkd->bhqd', p_own, v_own)
                + jnp.einsum('bhqjk,bhqjkd->bhqd', p_sel, v_sel))

    o = lax.map(one, jnp.arange(Sp // QC))
    o = jnp.moveaxis(o, 0, 2).reshape(B, H, Sp, D)[:, :, :S]
    return o.transpose(0, 2, 1, 3).reshape(B, S, H * D)


def rglru_mixer(xb, gate, conv_w, conv_b, w_a, b_a, w_x, b_x, lam):
    B, S, W = xb.shape
    xc = lax.conv_general_dilated(xb, conv_w, window_strides=(1,), padding=[(LRU_CONV - 1, 0)],
                                  dimension_numbers=('NWC', 'WIO', 'NWC'),
                                  feature_group_count=W) + conv_b
    xh = xc.reshape(B, S, LRU_BLOCKS, LRU_BW)
    r = jax.nn.sigmoid(jnp.einsum('bsnc,ncd->bsnd', xh, w_a).reshape(B, S, W) + b_a)
    i = jax.nn.sigmoid(jnp.einsum('bsnc,ncd->bsnd', xh, w_x).reshape(B, S, W) + b_x)
    log_a = (-LRU_C * r.astype(jnp.float32)) * jax.nn.softplus(-lam.astype(jnp.float32))
    a = jnp.exp(log_a)
    u = jnp.sqrt(-jnp.expm1(2.0 * log_a)) * (i * xc).astype(jnp.float32)

    def combine(left, right):
        a_l, b_l = left
        a_r, b_r = right
        return a_l * a_r, a_r * b_l + b_r

    _, h = lax.associative_scan(combine, (a, u), axis=1)
    return (h * jax.nn.gelu(gate.astype(jnp.float32))).astype(xb.dtype)


def setup_inputs(seed: int = 0) -> dict:
    key = jax.random.key(seed)
    keys = iter(jax.random.split(key, 32))
    L = DEPTH

    def dense(shape, fan_in):
        return jax.random.normal(next(keys), shape, jnp.float32) * fan_in ** -0.5

    def gain(shape):
        return 1.0 + 0.02 * jax.random.normal(next(keys), shape, jnp.float32)

    def bias(shape):
        return 0.02 * jax.random.normal(next(keys), shape, jnp.float32)

    x = jax.random.normal(next(keys), (BATCH, SEQ, D_MODEL), jnp.float32)
    attn_norm = gain((L, D_MODEL))
    w_in = dense((L, D_MODEL, IN_WIDTH), D_MODEL)
    mla_q_norm = gain((L, MLA_Q_RANK))
    mla_w_uq = dense((L, MLA_Q_RANK, MLA_HEADS * (MLA_NOPE + MLA_ROPE)), MLA_Q_RANK)
    mla_kv_norm = gain((L, MLA_KV_RANK))
    mla_w_ukv = dense((L, MLA_KV_RANK, MLA_HEADS * (MLA_NOPE + MLA_V)), MLA_KV_RANK)
    gla_w_a2 = dense((L, GLA_GATE_RANK, GLA_HEADS * GLA_DK), GLA_GATE_RANK)
    gla_b_a2 = bias((L, GLA_HEADS * GLA_DK))
    gla_head_norm = gain((L, GLA_DV))
    lru_conv_w = dense((L, LRU_CONV, 1, LRU_WIDTH), LRU_CONV)
    lru_conv_b = bias((L, LRU_WIDTH))
    lru_w_a = dense((L, LRU_BLOCKS, LRU_BW, LRU_BW), LRU_BW)
    lru_b_a = bias((L, LRU_WIDTH))
    lru_w_x = dense((L, LRU_BLOCKS, LRU_BW, LRU_BW), LRU_BW)
    lru_b_x = bias((L, LRU_WIDTH))
    u = jax.random.uniform(next(keys), (L, LRU_WIDTH), jnp.float32, 0.9, 0.999)
    a0 = u ** (1.0 / LRU_C)
    lru_lambda = jnp.log(a0) - jnp.log1p(-a0)
    w_out = dense((L, MIX_WIDTH, D_MODEL), MIX_WIDTH)
    ffn_norm = gain((L, D_MODEL))
    w_ffn_in = dense((L, D_MODEL, 2 * FFN_HIDDEN), D_MODEL)
    w_ffn_out = dense((L, FFN_HIDDEN, D_MODEL), FFN_HIDDEN)
    final_norm = gain((D_MODEL,))
    return {
        "x": x, "attn_norm": attn_norm, "w_in": w_in,
        "mla_q_norm": mla_q_norm, "mla_w_uq": mla_w_uq, "mla_kv_norm": mla_kv_norm, "mla_w_ukv": mla_w_ukv,
        "gla_w_a2": gla_w_a2, "gla_b_a2": gla_b_a2, "gla_head_norm": gla_head_norm,
        "lru_conv_w": lru_conv_w, "lru_conv_b": lru_conv_b, "lru_w_a": lru_w_a, "lru_b_a": lru_b_a,
        "lru_w_x": lru_w_x, "lru_b_x": lru_b_x, "lru_lambda": lru_lambda,
        "w_out": w_out, "ffn_norm": ffn_norm, "w_ffn_in": w_ffn_in, "w_ffn_out": w_ffn_out,
        "final_norm": final_norm,
    }


def reference(x, attn_norm, w_in, mla_q_norm, mla_w_uq, mla_kv_norm, mla_w_ukv,
              gla_w_a2, gla_b_a2, gla_head_norm,
              lru_conv_w, lru_conv_b, lru_w_a, lru_b_a, lru_w_x, lru_b_x, lru_lambda,
              w_out, ffn_norm, w_ffn_in, w_ffn_out, final_norm):
    S = x.shape[1]
    cos_mla, sin_mla = rope_tables(S, MLA_ROPE)
    cos_moba, sin_moba = rope_tables(S, MOBA_ROT)
    for l in range(DEPTH):
        h = rms_norm(x, attn_norm[l])
        (mq, mkv, mkr, gq, gk, gv, ga, gg, bq, bk, bv, rx, rg) = jnp.split(h @ w_in[l], SPLIT_POINTS, axis=-1)
        y_a = mla_mixer(mq, mkv, mkr, mla_q_norm[l], mla_w_uq[l], mla_kv_norm[l], mla_w_ukv[l], cos_mla, sin_mla)
        y_b = gla_mixer(gq, gk, gv, ga, gg, gla_w_a2[l], gla_b_a2[l], gla_head_norm[l])
        y_c = moba_mixer(bq, bk, bv, cos_moba, sin_moba)
        y_d = rglru_mixer(rx, rg, lru_conv_w[l], lru_conv_b[l], lru_w_a[l], lru_b_a[l],
                          lru_w_x[l], lru_b_x[l], lru_lambda[l])
        y = jnp.concatenate([y_a.astype(x.dtype), y_b.astype(x.dtype), y_c.astype(x.dtype), y_d.astype(x.dtype)], axis=-1)
        x = x + y @ w_out[l]
        h = rms_norm(x, ffn_norm[l])
        g, up = jnp.split(h @ w_ffn_in[l], 2, axis=-1)
        x = x + (jax.nn.silu(g) * up) @ w_ffn_out[l]
    return rms_norm(x, final_norm)
```

```cpp
#include <hip/hip_runtime.h>
#include <hip/hip_cooperative_groups.h>
#include <cstdio>
#include <cstdint>
#include <cmath>
namespace cg = cooperative_groups;
namespace pg8 {
#define PG8_LAS __attribute__((address_space(3)))
typedef unsigned short bf16_t;
typedef short bf16x8 __attribute__((ext_vector_type(8)));
typedef float f32x4 __attribute__((ext_vector_type(4)));
typedef unsigned u32x4 __attribute__((ext_vector_type(4)));
constexpr int BM = 256, BK = 64, HALF = 128, HTB = HALF * BK * 2  , STAGE_BYTES = 8 * HTB, NXCD = 8, WGM = 4;

__host__ __device__ __forceinline__ int lds_byte(int r, int c) { const int st = (r >> 4) * 2 + (c >> 5), rr = r & 15, cc = c & 31, ob = rr * 64 + cc * 2; return st * 1024 + (ob ^ (((ob >> 9) & 1) << 5)); }
__host__ __device__ __forceinline__ void stage_rc(int b, int& R, int& C) { const int st = b / 1024, sb = b % 1024, swz = sb ^ (((sb >> 9) & 1) << 5); R = (st >> 1) * 16 + swz / 64; C = (st & 1) * 32 + (swz % 64) / 2; }
__host__ __device__ __forceinline__ int perm32(int rho) { const int n = rho >> 4, i = rho & 15; return 8 * (i >> 2) + 4 * n + (i & 3); }

struct Unit { int pm, pn; };
struct Gemm { const bf16_t* A; const bf16_t* Bt; int M, N, K; };

struct StaticOrder {
    int nM, nN, nwg, G, c;
    __host__ __device__ void init(int M, int N, int G_, int c_) { nM = M / BM; nN = N / BM; nwg = nM * nN; G = G_; c = c_; }
    __host__ __device__ bool next(int i, Unit& u) const {
        const long L = (long)i * G + c; if (L >= nwg) return false;
        int wgid = (int)L; { const int q = nwg / NXCD, r = nwg % NXCD, xcd = wgid % NXCD, off = wgid / NXCD; wgid = (xcd < r ? xcd * (q + 1) : r * (q + 1) + (xcd - r) * q) + off; }
        const int nig = WGM * nN, gid = wgid / nig, fm = gid * WGM, gsz = (nM - fm) < WGM ? (nM - fm) : WGM;
        u.pm = fm + ((wgid % nig) % gsz); u.pn = (wgid % nig) / gsz; return true;
    }
    __device__ __forceinline__ void a_ready(const Unit&) const {}
    __device__ __forceinline__ void done(const Unit&) const {}
};

__device__ __forceinline__ unsigned cvt_pk_bf16(float lo, float hi) { unsigned r; asm volatile("v_cvt_pk_bf16_f32 %0, %1, %2" : "=v"(r) : "v"(lo), "v"(hi)); return r; }
template <class Epi, class Sched, bool ALIGN_EPI = false, bool SP2 = false>
__device__ __forceinline__ void gemm_phase(PG8_LAS unsigned char* lds, const Gemm g, const Sched& S, const Epi& E) {
    int tid_ = threadIdx.x; asm volatile("" : "+v"(tid_));
    const int tid = tid_, wid = __builtin_amdgcn_readfirstlane(tid >> 6), lane = tid & 63, wr = wid >> 2, wc = wid & 3, fr = lane & 15, fq = lane >> 4;
    const int K = g.K, nt = K / BK;
    unsigned voffA[2], voffB[2];
#pragma unroll
    for (int i = 0; i < 2; ++i) { int R, C; stage_rc(tid * 16 + i * 8192, R, C); const int Rb = Epi::PERM ? ((R & ~31) + perm32(R & 31)) : R;
        voffA[i] = (unsigned)(R * K + C) * 2u; voffB[i] = (unsigned)(Rb * K + C) * 2u; }
    const size_t kstep = (size_t)(BK * 2);
    const size_t hstep = (size_t)HALF * K * 2;
    const size_t tstep = 2 * hstep;
    const unsigned ldsw = (unsigned)wid * 1024u;
    const int aoff = lds_byte(wr * 64 + fr, fq * 8), boff = lds_byte(wc * 32 + fr, fq * 8);
#define PG8_SA(b, h) (((b) * 2 + (h)) * HTB)
#define PG8_SB(b, h) ((4 + (b) * 2 + (h)) * HTB)
#define PG8_STAGE(bufoff, gbase, voff) do { _Pragma("unroll") for (int _i = 0; _i < 2; ++_i) \
        __builtin_amdgcn_global_load_lds((const unsigned*)((const char*)(gbase) + (voff)[_i]), (PG8_LAS unsigned*)(lds + (bufoff) + ldsw + _i * 8192), 16, 0, 0); } while (0)
#define PG8_LDA(dst, b, h) do { _Pragma("unroll") for (int m = 0; m < 4; ++m) _Pragma("unroll") for (int k = 0; k < 2; ++k) dst[m][k] = *(const PG8_LAS bf16x8*)(lds + PG8_SA(b, h) + aoff + m * 2048 + k * 1024); } while (0)
#define PG8_LDB(dst, b, h) do { _Pragma("unroll") for (int n = 0; n < 2; ++n) _Pragma("unroll") for (int k = 0; k < 2; ++k) dst[n][k] = *(const PG8_LAS bf16x8*)(lds + PG8_SB(b, h) + boff + n * 2048 + k * 1024); } while (0)
#define PG8_MMA(ai, bj, At, Bt) do { __builtin_amdgcn_s_setprio(1); _Pragma("unroll") for (int m = 0; m < 4; ++m) _Pragma("unroll") for (int n = 0; n < 2; ++n) _Pragma("unroll") for (int k = 0; k < 2; ++k) \
        acc[ai][bj][m][n] = __builtin_amdgcn_mfma_f32_16x16x32_bf16(Bt[n][k], At[m][k], acc[ai][bj][m][n], 0, 0, 0); __builtin_amdgcn_s_setprio(0); } while (0)
#define PG8_WAIT_V(n) asm volatile("s_waitcnt vmcnt(" #n ")" ::: "memory")
#define PG8_WAIT_L(n) asm volatile("s_waitcnt lgkmcnt(" #n ")" ::: "memory")
#define PG8_BAR __builtin_amdgcn_s_barrier()
#define PG8_SCHED __builtin_amdgcn_sched_barrier(0)
    Unit cur, nxt; int ui = 0;
    if (!S.next(0, cur)) return;
    f32x4 acc[2][2][4][2];
#pragma unroll
    for (int a = 0; a < 2; ++a)
#pragma unroll
        for (int b = 0; b < 2; ++b)
#pragma unroll
            for (int m = 0; m < 4; ++m)
#pragma unroll
                for (int n = 0; n < 2; ++n) acc[a][b][m][n] = (f32x4){0.f, 0.f, 0.f, 0.f};
    bf16x8 At[4][2], B0[2][2], B1[2][2];
    const char* cA = (const char*)g.A + (size_t)cur.pm * tstep; const char* cB = (const char*)g.Bt + (size_t)cur.pn * tstep;
    S.a_ready(cur);
    if constexpr (SP2) {
        PG8_STAGE(PG8_SB(0, 0), cB, voffB); PG8_STAGE(PG8_SB(0, 1), cB + hstep, voffB); PG8_STAGE(PG8_SA(0, 0), cA, voffA); PG8_STAGE(PG8_SA(0, 1), cA + hstep, voffA);
        if (wr == 1) PG8_BAR;
        PG8_WAIT_V(2); PG8_BAR;
        PG8_STAGE(PG8_SB(1, 0), cB + kstep, voffB); PG8_STAGE(PG8_SA(1, 0), cA + kstep, voffA); PG8_STAGE(PG8_SB(1, 1), cB + hstep + kstep, voffB);
        PG8_WAIT_V(6); PG8_BAR;
    } else {
        PG8_STAGE(PG8_SB(0, 0), cB, voffB); PG8_STAGE(PG8_SA(0, 0), cA, voffA); PG8_STAGE(PG8_SB(0, 1), cB + hstep, voffB); PG8_STAGE(PG8_SA(0, 1), cA + hstep, voffA);
        if (wr == 1) PG8_BAR;
        PG8_WAIT_V(4); PG8_BAR;
        PG8_STAGE(PG8_SB(1, 0), cB + kstep, voffB); PG8_STAGE(PG8_SA(1, 0), cA + kstep, voffA); PG8_STAGE(PG8_SB(1, 1), cB + hstep + kstep, voffB);
        PG8_WAIT_V(6); PG8_BAR;
    }
    for (;;) {
        const bool has_next = S.next(ui + 1, nxt);
        const char* nA = has_next ? (const char*)g.A + (size_t)nxt.pm * tstep : cA; const char* nB = has_next ? (const char*)g.Bt + (size_t)nxt.pn * tstep : cB;
        for (int t = 0; t < nt; t += 2) {
            const bool last = (t == nt - 2);
            const char* a1 = cA + (size_t)(t + 1) * kstep;
            const char* a2 = last ? nA : cA + (size_t)(t + 2) * kstep; const char* b2 = last ? nB : cB + (size_t)(t + 2) * kstep;
            const char* a3 = a2 + kstep; const char* b3 = b2 + kstep;
            if (last && has_next) S.a_ready(nxt);
            if constexpr (SP2) {
            PG8_LDB(B0, 0, 0); PG8_LDB(B1, 0, 1); PG8_SCHED; PG8_LDA(At, 0, 0); PG8_STAGE(PG8_SA(1, 1), a1 + hstep, voffA);
            PG8_WAIT_V(8); PG8_WAIT_L(0); PG8_BAR; PG8_MMA(0, 0, At, B0); PG8_MMA(0, 1, At, B1); PG8_BAR; PG8_SCHED;
            PG8_LDA(At, 0, 1); PG8_STAGE(PG8_SB(0, 0), b2, voffB); PG8_STAGE(PG8_SB(0, 1), b2 + hstep, voffB); PG8_STAGE(PG8_SA(0, 0), a2, voffA);
            PG8_WAIT_V(8); PG8_WAIT_L(0); PG8_BAR; PG8_MMA(1, 0, At, B0); PG8_MMA(1, 1, At, B1); PG8_BAR; PG8_SCHED;
            PG8_LDB(B0, 1, 0); PG8_LDB(B1, 1, 1); PG8_SCHED; PG8_LDA(At, 1, 0); PG8_STAGE(PG8_SA(0, 1), a2 + hstep, voffA);
            PG8_WAIT_V(8); PG8_WAIT_L(0); PG8_BAR; PG8_MMA(0, 0, At, B0); PG8_MMA(0, 1, At, B1); PG8_BAR; PG8_SCHED;
            PG8_LDA(At, 1, 1); PG8_STAGE(PG8_SB(1, 0), b3, voffB); PG8_STAGE(PG8_SB(1, 1), b3 + hstep, voffB); PG8_STAGE(PG8_SA(1, 0), a3, voffA);
            PG8_WAIT_V(8); PG8_WAIT_L(0); PG8_BAR; PG8_MMA(1, 0, At, B0); PG8_MMA(1, 1, At, B1); PG8_BAR; PG8_SCHED;
            } else {
            PG8_LDB(B0, 0, 0); PG8_SCHED; PG8_LDA(At, 0, 0); PG8_STAGE(PG8_SA(1, 1), a1 + hstep, voffA);
            PG8_WAIT_L(8); PG8_BAR; PG8_WAIT_L(0); PG8_MMA(0, 0, At, B0); PG8_BAR; PG8_SCHED;
            PG8_LDB(B1, 0, 1); PG8_STAGE(PG8_SB(0, 0), b2, voffB);
            PG8_BAR; PG8_WAIT_L(0); PG8_MMA(0, 1, At, B1); PG8_BAR;
            PG8_LDA(At, 0, 1); PG8_STAGE(PG8_SA(0, 0), a2, voffA);
            PG8_BAR; PG8_WAIT_L(0); PG8_MMA(1, 0, At, B0); PG8_BAR; PG8_SCHED;
            PG8_STAGE(PG8_SB(0, 1), b2 + hstep, voffB);
            PG8_WAIT_V(6); PG8_BAR; PG8_MMA(1, 1, At, B1); PG8_BAR;
            PG8_LDB(B0, 1, 0); PG8_SCHED; PG8_LDA(At, 1, 0); PG8_STAGE(PG8_SA(0, 1), a2 + hstep, voffA);
            PG8_WAIT_L(8); PG8_BAR; PG8_WAIT_L(0); PG8_MMA(0, 0, At, B0); PG8_BAR; PG8_SCHED;
            PG8_LDB(B1, 1, 1); PG8_STAGE(PG8_SB(1, 0), b3, voffB);
            PG8_BAR; PG8_WAIT_L(0); PG8_MMA(0, 1, At, B1); PG8_BAR;
            PG8_LDA(At, 1, 1); PG8_STAGE(PG8_SA(1, 0), a3, voffA);
            PG8_BAR; PG8_WAIT_L(0); PG8_MMA(1, 0, At, B0); PG8_BAR; PG8_SCHED;
            PG8_STAGE(PG8_SB(1, 1), b3 + hstep, voffB);
            PG8_WAIT_V(6); PG8_BAR; PG8_MMA(1, 1, At, B1); PG8_BAR;
            }
        }
        if constexpr (ALIGN_EPI) { if (wr == 0) PG8_BAR; }
        if constexpr (!Epi::AFTER_DRAIN) { E(acc, cur, wr, wc, fr, fq); S.done(cur); }
        if (!has_next) break;
#pragma unroll
        for (int a = 0; a < 2; ++a)
#pragma unroll
            for (int b = 0; b < 2; ++b)
#pragma unroll
                for (int m = 0; m < 4; ++m)
#pragma unroll
                    for (int n = 0; n < 2; ++n) acc[a][b][m][n] = (f32x4){0.f, 0.f, 0.f, 0.f};
        cur = nxt; cA = nA; cB = nB; ++ui;
        if constexpr (ALIGN_EPI) { if (wr == 1) PG8_BAR; }
    }
    PG8_WAIT_V(0);
    if constexpr (!ALIGN_EPI) { if (wr == 0) PG8_BAR; }
    PG8_BAR;
    if constexpr (Epi::AFTER_DRAIN) { E.fused(acc, cur, wr, wc, fr, fq, lds, wid, lane); S.done(cur); }
#undef PG8_SA
#undef PG8_SB
#undef PG8_STAGE
#undef PG8_LDA
#undef PG8_LDB
#undef PG8_MMA
#undef PG8_WAIT_V
#undef PG8_WAIT_L
#undef PG8_BAR
#undef PG8_SCHED
}
}

namespace mk {
#define LAS __attribute__((address_space(3)))
using pg8::f32x4; using pg8::u32x4; using pg8::bf16_t; using pg8::Unit; using pg8::cvt_pk_bf16;
typedef float f32x2 __attribute__((ext_vector_type(2)));
typedef unsigned u32x2 __attribute__((ext_vector_type(2)));

constexpr int T = 16384, S = 4096, DM = 1024, NIN = 3584, NPJ = 1280, FF = 2816, NFI = 5632, INW = 2480;
constexpr float EPS = 1e-6f;
constexpr float LOG2E = 1.4426950408889634f;
constexpr float C_MLA = 0.10206207261596577f * LOG2E;
constexpr float C_MOBA = 0.125f * LOG2E;
constexpr float NEG_INF = -INFINITY;

constexpr size_t MiB = 1u << 20, KiB = 1024;
constexpr size_t WS_SSX = 0, WS_SSQ = 1 * MiB, WS_SSK = 1 * MiB + 256 * KiB, WS_KPGA = 1 * MiB + 512 * KiB, WS_ROPEA = 4 * MiB + 512 * KiB,
                 WS_ROPEM = 5 * MiB, WS_KMEAN = 5 * MiB + 256 * KiB, WS_GDEC = 5 * MiB + 512 * KiB, WS_AGGA = 6 * MiB, WS_AGGU = 7 * MiB, WS_CARRY = 8 * MiB,
                 WS_LRW = 9 * MiB,
                 WS_WIN = 10 * MiB, WS_WOUT = 24 * MiB, WS_WFI = 28 * MiB, WS_WFO = 39 * MiB, WS_XBF = 45 * MiB, WS_YCAT = 77 * MiB, WS_GDS = 109 * MiB,
                 WS_LRA = 117 * MiB, WS_LRU = 133 * MiB, WS_ACT = 149 * MiB, WS_PROJ = 149 * MiB, WS_QA = 189 * MiB, WS_KA = 201 * MiB, WS_VTA = 213 * MiB,
                 WS_QM = 221 * MiB, WS_KM = 229 * MiB, WS_VTM = 237 * MiB, WS_WFQ = 245 * MiB, WS_WFKV = 248 * MiB, WS_END = 254 * MiB;
constexpr int LDS_BYTES = 147456;

struct Params { const float* in[22]; float* out; unsigned char* ws; };
enum { I_X = 0, I_ATTN_NORM, I_W_IN, I_Q_NORM, I_W_UQ, I_KV_NORM, I_W_UKV, I_GLA_WA2, I_GLA_BA2, I_GLA_HN, I_CONV_W, I_CONV_B, I_LRU_WA, I_LRU_BA, I_LRU_WX, I_LRU_BX,
       I_LRU_LAM, I_W_OUT, I_FFN_NORM, I_W_FFN_IN, I_W_FFN_OUT, I_FINAL_NORM };

#define CAS __attribute__((address_space(4)))
__device__ __forceinline__ const float* INP(int i) { const CAS char* ka = (const CAS char*)__builtin_amdgcn_kernarg_segment_ptr(); asm volatile("" : "+s"(ka)); return *(const float* const CAS*)(ka + 8 * i); }
__device__ __forceinline__ float* OUTP() { return (float*)INP(22); }
__device__ __forceinline__ unsigned char* WSP() { return (unsigned char*)INP(23); }

__device__ __forceinline__ float bf2f(unsigned h) { return __uint_as_float(h << 16); }
__device__ __forceinline__ float bflo(unsigned w) { return __uint_as_float(w << 16); }
__device__ __forceinline__ float bfhi(unsigned w) { return __uint_as_float(w & 0xffff0000u); }

__device__ __forceinline__ float wave_sum(float v) {
#pragma unroll
    for (int o = 1; o < 64; o <<= 1) v += __shfl_xor(v, o);
    return v;
}
__device__ __forceinline__ float sigmoidf_(float z) { return __builtin_amdgcn_rcpf(1.f + __expf(-z)); }
__device__ __forceinline__ float logsigmoidf_(float z) { return fminf(z, 0.f) - __logf(1.f + __expf(-fabsf(z))); }
__device__ __forceinline__ float gelu_tanh(float x) { const float u = 0.7978845608028654f * (x + 0.044715f * x * x * x); const float t = 1.f - 2.f * __builtin_amdgcn_rcpf(__expf(2.f * u) + 1.f); return 0.5f * x * (1.f + t); }
__device__ __forceinline__ void store8(bf16_t* p, f32x4 a, f32x4 b) { u32x4 w; w.x = cvt_pk_bf16(a[0], a[1]); w.y = cvt_pk_bf16(a[2], a[3]); w.z = cvt_pk_bf16(b[0], b[1]); w.w = cvt_pk_bf16(b[2], b[3]); *(u32x4*)p = w; }
typedef __bf16 bf16x2_t __attribute__((ext_vector_type(2)));
__device__ __forceinline__ unsigned cvt_pk_safe(float lo, float hi) { const f32x2 v = {lo, hi}; const bf16x2_t b = __builtin_convertvector(v, bf16x2_t); return __builtin_bit_cast(unsigned, b); }
__device__ __forceinline__ unsigned pk2(float lo, float hi) { return cvt_pk_safe(lo, hi); }
__device__ __forceinline__ unsigned f2bf(float f) { return cvt_pk_safe(f, 0.f) & 0xffffu; }
__device__ __forceinline__ float sum4(f32x4 a) { return (a[0] + a[1]) + (a[2] + a[3]); }
__device__ __forceinline__ float sq4(f32x4 a) { return (a[0] * a[0] + a[1] * a[1]) + (a[2] * a[2] + a[3] * a[3]); }
__device__ __forceinline__ void load_rstd8(const float* ssx, int rbase, float (&rs)[2][4]) {
    f32x4 t[2][4];
#pragma unroll
    for (int ai = 0; ai < 2; ++ai)
#pragma unroll
        for (int m = 0; m < 4; ++m) t[ai][m] = *(const f32x4*)(ssx + (size_t)(rbase + ai * 128 + m * 16) * 4);
#pragma unroll
    for (int ai = 0; ai < 2; ++ai)
#pragma unroll
        for (int m = 0; m < 4; ++m) rs[ai][m] = __builtin_amdgcn_rsqf(sum4(t[ai][m]) * (1.f / 1024.f) + EPS);
}

#define XB_TMO      128
#define XB_XCNT(j)  (256  + 64 * (j))
#define XB_XSUB(j)  (1280 + 64 * (j))
#define XB_XGEN(j)  (2304 + 64 * (j))
#define XB_TOP      3328
#define XB_TOPGEN   3392
#define XCD_BAR_WORDS 3456
#define XB_SPIN_CAP (1u << 18)

__device__ __forceinline__ unsigned xb_ld(unsigned* p)              { return __hip_atomic_load(p, __ATOMIC_RELAXED, __HIP_MEMORY_SCOPE_AGENT); }
__device__ __forceinline__ unsigned xb_add(unsigned* p, unsigned v) { return __hip_atomic_fetch_add(p, v, __ATOMIC_RELAXED, __HIP_MEMORY_SCOPE_AGENT); }
__device__ __forceinline__ unsigned xb_xcc_id() { return (unsigned)__builtin_amdgcn_s_getreg((3 << 11) | 20) & 0xFu; }
#define XB_SPIN(cond, bar) do { unsigned _sp = 0; while (cond) { __builtin_amdgcn_s_sleep(1); \
    if ((++_sp & 255u) == 0u) { if (xb_ld(&(bar)[XB_TMO])) break; if (_sp > XB_SPIN_CAP) { atomicAdd(&(bar)[XB_TMO], 1u); break; } } } } while (0)

struct XcdBarrier {
    unsigned* bar; unsigned x;
    volatile LAS unsigned* st;
};

__device__ __forceinline__ XcdBarrier xcd_barrier_post(unsigned* bar, volatile LAS unsigned* st) {
    XcdBarrier b; b.bar = bar; b.x = xb_xcc_id(); b.st = st;
    if (threadIdx.x == 0) (void)xb_add(&bar[XB_XCNT(b.x)], 1u);
    return b;
}
__device__ __forceinline__ void xcd_barrier_complete(unsigned* bar, unsigned x, unsigned& nloc, unsigned& nx) {
    const unsigned G = gridDim.x * gridDim.y * gridDim.z;
    unsigned sum, cnt, mine, sp = 0u;
    for (;;) {
        sum = 0u; cnt = 0u; mine = 0u;
#pragma unroll
        for (unsigned j = 0; j < 16; ++j) { const unsigned c = xb_ld(&bar[XB_XCNT(j)]); sum += c; cnt += (c > 0u) ? 1u : 0u; mine = (j == x) ? c : mine; }
        if (sum == G) break;
        __builtin_amdgcn_s_sleep(1);
        if ((++sp & 255u) == 0u) { if (xb_ld(&bar[XB_TMO])) break; if (sp > XB_SPIN_CAP) { atomicAdd(&bar[XB_TMO], 1u); break; } }
    }
    nloc = mine > 0u ? mine : 1u; nx = cnt > 0u ? cnt : 1u;
}

__device__ __forceinline__ void xcd_barrier(const XcdBarrier& b) {
    asm volatile("s_waitcnt vmcnt(0)" ::: "memory");
    __syncthreads();
    if (threadIdx.x == 0) {
        unsigned* bar = b.bar;
        __builtin_amdgcn_s_waitcnt(0);
        unsigned nloc = b.st[0], nx = b.st[1];
        if (nloc == 0u) { xcd_barrier_complete(bar, b.x, nloc, nx); b.st[0] = nloc; b.st[1] = nx; }
        const unsigned old = xb_add(&bar[XB_XSUB(b.x)], 1u);
        const unsigned gen = old / nloc;
        if (old + 1u == (gen + 1u) * nloc) {
            __builtin_amdgcn_fence(__ATOMIC_RELEASE, "agent");
            asm volatile("s_waitcnt vmcnt(0)" ::: "memory");
            const unsigned og = xb_add(&bar[XB_TOP], 1u);
            const unsigned tg = og / nx;
            if (og + 1u == (tg + 1u) * nx) xb_add(&bar[XB_TOPGEN], 1u);
            else XB_SPIN(xb_ld(&bar[XB_TOPGEN]) == tg, bar);
            __builtin_amdgcn_fence(__ATOMIC_ACQUIRE, "agent");
            xb_add(&bar[XB_XGEN(b.x)], 1u);
            asm volatile("s_waitcnt vmcnt(0)" ::: "memory");
        } else {
            XB_SPIN(xb_ld(&bar[XB_XGEN(b.x)]) == gen, bar);
            __builtin_amdgcn_fence(__ATOMIC_ACQUIRE, "agent");
            asm volatile("s_waitcnt vmcnt(0)" ::: "memory");
        }
    }
    __syncthreads();
}

__device__ __forceinline__ size_t ka_off(int bh, int s, int d);
__device__ __forceinline__ size_t km_off(int bh, int s, int d);
__device__ __forceinline__ size_t vf_off(int bh, int key, int dv);
struct EpiIn {
    static constexpr bool PERM = true, AFTER_DRAIN = false;
    unsigned char* ws;
    __device__ __forceinline__ void operator()(const f32x4 (&acc)[2][2][4][2], const Unit& u, int wr, int wc, int fr_, int fq_) const {
        int fr = fr_, fq = fq_; asm volatile("" : "+v"(fr), "+v"(fq));
        const int pn = u.pn;
        const float* ssx = (const float*)(ws + WS_SSX); float* ssq = (float*)(ws + WS_SSQ); float* ssk = (float*)(ws + WS_SSK); float* kpga = (float*)(ws + WS_KPGA);
        bf16_t* Qa = (bf16_t*)(ws + WS_QA); bf16_t* Ka = (bf16_t*)(ws + WS_KA); bf16_t* Vta = (bf16_t*)(ws + WS_VTA); bf16_t* Qm = (bf16_t*)(ws + WS_QM); bf16_t* Km = (bf16_t*)(ws + WS_KM); bf16_t* Vtm = (bf16_t*)(ws + WS_VTM);
        bf16_t* proj = (bf16_t*)(ws + WS_PROJ); const float* ropeM = (const float*)(ws + WS_ROPEM);
        float rs8[2][4]; load_rstd8(ssx, u.pm * 256 + wr * 64 + fr, rs8);
#pragma unroll
        for (int ai = 0; ai < 2; ++ai)
#pragma unroll
            for (int m = 0; m < 4; ++m) {
                int r = u.pm * 256 + ai * 128 + wr * 64 + m * 16 + fr; asm volatile("" : "+v"(r));
                const float rs = rs8[ai][m];
                f32x4 v[2][2];
#pragma unroll
                for (int bj = 0; bj < 2; ++bj)
#pragma unroll
                    for (int n = 0; n < 2; ++n) v[bj][n] = acc[ai][bj][m][n] * rs;
                const int b = r >> 12, s = r & 4095;
                if (pn == 0) {
                    float q = (sq4(v[0][0]) + sq4(v[0][1])) + (sq4(v[1][0]) + sq4(v[1][1]));
                    q += __shfl_xor(q, 16); q += __shfl_xor(q, 32);
                    if (fq == 0) ssq[(size_t)r * 4 + wc] = q;
                } else if (pn == 1) {
                    float q = sq4(v[0][0]) + sq4(v[0][1]);
                    q += __shfl_xor(q, 16); q += __shfl_xor(q, 32);
                    if (fq == 0) ssk[(size_t)r * 4 + wc] = q;
                    if (wc == 0) { float* o = kpga + (size_t)r * 48 + 8 * fq; *(f32x4*)o = v[1][0]; *(f32x4*)(o + 4) = v[1][1]; }
                    else if (wc == 1 && fq < 2) { float* o = kpga + (size_t)r * 48 + 32 + 8 * fq; *(f32x4*)o = v[1][0]; *(f32x4*)(o + 4) = v[1][1]; }
                } else if (pn == 2) {
#pragma unroll
                    for (int bj = 0; bj < 2; ++bj) { const int h = 2 * bj + (wc >> 1), d0 = (wc & 1) * 32 + 8 * fq;
                        store8(Qa + ((size_t)(b * 4 + h) * S + s) * 96 + d0, v[bj][0], v[bj][1]); }
                } else if (pn == 4) {
#pragma unroll
                    for (int bj = 0; bj < 2; ++bj) { const int h = 2 * bj + (wc >> 1), d0 = (wc & 1) * 32 + 8 * fq;
                        store8(Ka + ka_off(b * 4 + h, s, d0), v[bj][0], v[bj][1]); }
                } else if (pn == 3) {
                    store8(Qa + ((size_t)(b * 4 + wc) * S + s) * 96 + 64 + 8 * fq, v[0][0], v[0][1]);
                    store8(proj + (size_t)r * NPJ + 32 * wc + 8 * fq, v[1][0], v[1][1]);
                } else if (pn == 5 || pn == 11) {
                    bf16_t* base = (pn == 5) ? Vta : Vtm;
#pragma unroll
                    for (int bj = 0; bj < 2; ++bj)
#pragma unroll
                        for (int n = 0; n < 2; ++n)
#pragma unroll
                            for (int i = 0; i < 4; ++i) { const int cl = 128 * bj + 32 * wc + 8 * fq + 4 * n + i; base[vf_off(b * 4 + (cl >> 6), s, cl & 63)] = (bf16_t)f2bf(v[bj][n][i]); }
                } else if (pn == 6) {
                    store8(proj + (size_t)r * NPJ + 128 + 32 * wc + 8 * fq, v[0][0], v[0][1]);
                } else if (pn == 9 || pn == 10) {
                    const float sc = (pn == 9) ? C_MOBA : 1.f;
                    const bool rot = ((wc & 1) == 0) && (fq < 2);
                    f32x4 cs = (f32x4){1.f, 1.f, 1.f, 1.f}, sn = (f32x4){0.f, 0.f, 0.f, 0.f};
                    if (rot) { cs = *(const f32x4*)(ropeM + (size_t)s * 8 + 4 * fq); sn = *(const f32x4*)(ropeM + (size_t)S * 8 + (size_t)s * 8 + 4 * fq); }
#pragma unroll
                    for (int bj = 0; bj < 2; ++bj) { const int h = 2 * bj + (wc >> 1), p0 = (wc & 1) * 32 + 8 * fq;
                        f32x4 x1 = v[bj][0], x2 = v[bj][1];
                        if (rot) { const f32x4 o1 = x1 * cs - x2 * sn, o2 = x2 * cs + x1 * sn; x1 = o1; x2 = o2; }
                        bf16_t* dst = (pn == 9) ? Qm + ((size_t)(b * 4 + h) * S + s) * 64 + p0 : Km + km_off(b * 4 + h, s, p0);
                        store8(dst, x1 * sc, x2 * sc); }
                } else {
                    const int off = (pn == 7) ? 256 : (pn == 8) ? 512 : (pn == 12) ? 768 : 1024;
#pragma unroll
                    for (int bj = 0; bj < 2; ++bj) store8(proj + (size_t)r * NPJ + off + 128 * bj + 32 * wc + 8 * fq, v[bj][0], v[bj][1]);
                }
                asm volatile("" ::: "memory"); __builtin_amdgcn_sched_barrier(0);
            }
    }
};
struct EpiRes {
    static constexpr bool PERM = true, AFTER_DRAIN = true;
    const float* xold; float* xnew; unsigned char* ws;
    __device__ __forceinline__ void operator()(const f32x4 (&)[2][2][4][2], const Unit&, int, int, int, int) const {}
    __device__ __forceinline__ void fused(f32x4 (&acc)[2][2][4][2], const Unit& u, int wr, int wc, int fr, int fq, PG8_LAS unsigned char* lds, int wid, int lane) const {
        bf16_t* xbf = (bf16_t*)(ws + WS_XBF); float* ssx = (float*)(ws + WS_SSX);
        PG8_LAS float* P = (PG8_LAS float*)lds;
#pragma unroll
        for (int ai = 0; ai < 2; ++ai)
#pragma unroll
            for (int m = 0; m < 4; ++m) {
                const int rl = ai * 128 + wr * 64 + m * 16 + fr, r = u.pm * 256 + rl; float q = 0.f;
#pragma unroll
                for (int bj = 0; bj < 2; ++bj) { const size_t off = (size_t)r * DM + u.pn * 256 + 128 * bj + 32 * wc + 8 * fq;
                    const f32x4 o0 = *(const f32x4*)(xold + off) + acc[ai][bj][m][0], o1 = *(const f32x4*)(xold + off + 4) + acc[ai][bj][m][1];
                    *(f32x4*)(xnew + off) = o0; *(f32x4*)(xnew + off + 4) = o1; store8(xbf + off, o0, o1); q += sq4(o0) + sq4(o1); }
                q += __shfl_xor(q, 16); q += __shfl_xor(q, 32);
                if (fq == 0) P[rl * 4 + wc] = q;
                if (m & 1) { asm volatile("" ::: "memory"); __builtin_amdgcn_sched_barrier(0); }
            }
        asm volatile("s_waitcnt lgkmcnt(0)" ::: "memory"); __builtin_amdgcn_s_barrier(); asm volatile("" ::: "memory");
        const int t = wid * 64 + lane;
        if (t < 256) { const f32x4 pv = *(const PG8_LAS f32x4*)(P + t * 4); ssx[(size_t)(u.pm * 256 + t) * 4 + u.pn] = sum4(pv); }
        asm volatile("s_waitcnt lgkmcnt(0)" ::: "memory"); __builtin_amdgcn_s_barrier(); asm volatile("" ::: "memory");
    }
};
struct EpiResFinal {
    static constexpr bool PERM = true, AFTER_DRAIN = true;
    const float* xold; float* out; const float* gain; float* slots  ; unsigned* cnt  ;
    __device__ __forceinline__ void operator()(const f32x4 (&)[2][2][4][2], const Unit&, int, int, int, int) const {}
    __device__ __forceinline__ void fused(f32x4 (&acc)[2][2][4][2], const Unit& u, int wr, int wc, int fr, int fq, PG8_LAS unsigned char* lds, int wid, int lane) const {
        PG8_LAS float* P = (PG8_LAS float*)lds;
        PG8_LAS float* Sr = (PG8_LAS float*)(lds + 4096);
#pragma unroll
        for (int ai = 0; ai < 2; ++ai)
#pragma unroll
            for (int m = 0; m < 4; ++m) {
                const int rl = ai * 128 + wr * 64 + m * 16 + fr, r = u.pm * 256 + rl; float q = 0.f;
#pragma unroll
                for (int bj = 0; bj < 2; ++bj) { const size_t off = (size_t)r * DM + u.pn * 256 + 128 * bj + 32 * wc + 8 * fq;
                    acc[ai][bj][m][0] += *(const f32x4*)(xold + off); acc[ai][bj][m][1] += *(const f32x4*)(xold + off + 4); q += sq4(acc[ai][bj][m][0]) + sq4(acc[ai][bj][m][1]); }
                q += __shfl_xor(q, 16); q += __shfl_xor(q, 32);
                if (fq == 0) P[rl * 4 + wc] = q;
                if (m & 1) { asm volatile("" ::: "memory"); __builtin_amdgcn_sched_barrier(0); }
            }
        asm volatile("s_waitcnt lgkmcnt(0)" ::: "memory"); __builtin_amdgcn_s_barrier(); asm volatile("" ::: "memory");
        const int t = wid * 64 + lane;
        if (t < 256) { const f32x4 pv = *(const PG8_LAS f32x4*)(P + t * 4); __hip_atomic_store(slots + (size_t)(u.pm * 256 + t) * 4 + u.pn, sum4(pv), __ATOMIC_RELAXED, __HIP_MEMORY_SCOPE_AGENT); }
        asm volatile("s_waitcnt vmcnt(0)" ::: "memory");
        __builtin_amdgcn_s_barrier(); asm volatile("" ::: "memory");
        if (t == 0) {
            __hip_atomic_fetch_add(cnt + 64 * u.pm, 1u, __ATOMIC_RELAXED, __HIP_MEMORY_SCOPE_AGENT);
            unsigned sp = 0u;
            while (__hip_atomic_load(cnt + 64 * u.pm, __ATOMIC_RELAXED, __HIP_MEMORY_SCOPE_AGENT) < 4u) { __builtin_amdgcn_s_sleep(2); if (++sp > (1u << 22)) break; }
            __builtin_amdgcn_fence(__ATOMIC_ACQUIRE, "agent");
        }
        asm volatile("s_waitcnt vmcnt(0) lgkmcnt(0)" ::: "memory"); __builtin_amdgcn_s_barrier(); asm volatile("" ::: "memory");
        if (t < 256) { const float* sl = slots + (size_t)(u.pm * 256 + t) * 4; float s = 0.f;
#pragma unroll
            for (int k = 0; k < 4; ++k) s += __hip_atomic_load(sl + k, __ATOMIC_RELAXED, __HIP_MEMORY_SCOPE_AGENT);
            Sr[t] = __builtin_amdgcn_rsqf(s * (1.f / 1024.f) + EPS); }
        asm volatile("s_waitcnt vmcnt(0) lgkmcnt(0)" ::: "memory"); __builtin_amdgcn_s_barrier(); asm volatile("" ::: "memory");
#pragma unroll
        for (int ai = 0; ai < 2; ++ai)
#pragma unroll
            for (int m = 0; m < 4; ++m) {
                const int rl = ai * 128 + wr * 64 + m * 16 + fr, r = u.pm * 256 + rl; const float rs = Sr[rl];
#pragma unroll
                for (int bj = 0; bj < 2; ++bj) { const int col = u.pn * 256 + 128 * bj + 32 * wc + 8 * fq; const size_t off = (size_t)r * DM + col;
                    *(f32x4*)(out + off) = acc[ai][bj][m][0] * rs * *(const f32x4*)(gain + col); *(f32x4*)(out + off + 4) = acc[ai][bj][m][1] * rs * *(const f32x4*)(gain + col + 4); }
            }
    }
};
struct EpiSwi {
    static constexpr bool PERM = true, AFTER_DRAIN = false;
    unsigned char* ws;
    __device__ __forceinline__ void operator()(const f32x4 (&acc)[2][2][4][2], const Unit& u, int wr, int wc, int fr_, int fq_) const {
        int fr = fr_, fq = fq_; asm volatile("" : "+v"(fr), "+v"(fq));
        const float* ssx = (const float*)(ws + WS_SSX); bf16_t* act = (bf16_t*)(ws + WS_ACT);
        float rs8[2][4]; load_rstd8(ssx, u.pm * 256 + wr * 64 + fr, rs8);
#pragma unroll
        for (int ai = 0; ai < 2; ++ai)
#pragma unroll
            for (int m = 0; m < 4; ++m) {
                const int r = u.pm * 256 + ai * 128 + wr * 64 + m * 16 + fr;
                const float rs = rs8[ai][m];
                f32x4 o[2];
                const float nrl = -rs * LOG2E, rs2 = rs * rs;
#pragma unroll
                for (int n = 0; n < 2; ++n) { const f32x4 g = acc[ai][0][m][n], up = acc[ai][1][m][n];
#pragma unroll
                    for (int i = 0; i < 4; ++i) o[n][i] = (g[i] * up[i]) * (rs2 * __builtin_amdgcn_rcpf(1.f + __builtin_amdgcn_exp2f(g[i] * nrl))); }
                store8(act + (size_t)r * FF + u.pn * 128 + 32 * wc + 8 * fq, o[0], o[1]);
                __builtin_amdgcn_sched_barrier(0);
            }
    }
};

__device__ __forceinline__ int sigperm(int p) { return p < 16 ? (((p >> 2) & 1) * 8 + ((p >> 3) & 1) * 4 + (p & 3)) : p; }
struct MapIn { const float* win; const float* wfq; const float* wfkv;
    __device__ __forceinline__ void operator()(int n, const float*& src, int& ld, int& col) const {
        const int t = n >> 8, c = n & 255; src = win; ld = INW; col = 0;
        switch (t) {
            case 0: col = c; break;
            case 1: if (c < 128) col = 256 + c; else if (c < 160) col = 384 + (c - 128); else if (c < 176) col = 928 + (c - 160); else src = nullptr; break;
            case 2: src = wfq; ld = 384; col = (c >> 6) * 96 + (c & 63); break;
            case 3: if (c < 128) { src = wfq; ld = 384; col = (c >> 5) * 96 + 64 + (c & 31); } else col = 416 + (c - 128); break;
            case 4: src = wfkv; ld = 512; col = (c >> 6) * 128 + (c & 63); break;
            case 5: src = wfkv; ld = 512; col = (c >> 6) * 128 + 64 + (c & 63); break;
            case 6: if (c < 128) col = 544 + c; else src = nullptr; break;
            case 7: col = 672 + c; break;
            case 8: col = 944 + c; break;
            case 9: col = 1200 + (c & ~63) + sigperm(c & 63); break;
            case 10: col = 1456 + (c & ~63) + sigperm(c & 63); break;
            case 11: col = 1712 + c; break;
            case 12: col = 1968 + c; break;
            default: col = 2224 + c; break;
        }
    }
};
struct MapPlain { const float* w; int N;
    __device__ __forceinline__ void operator()(int n, const float*& src, int& ld, int& col) const { src = w; ld = N; col = n; } };
struct MapFfnIn { const float* w;
    __device__ __forceinline__ void operator()(int n, const float*& src, int& ld, int& col) const { const int t = n >> 8, c = n & 255; src = w; ld = NFI; col = (c < 128) ? (128 * t + c) : (FF + 128 * t + (c - 128)); } };
template <class Map> __device__ __forceinline__ void transpose_item(const Map& mp, int K, int nblk, bf16_t* WT, const float* gain, LAS float* scr, int item, int lane) {
    const int kb = item / nblk, nb = item % nblk, k0 = 64 * kb, n0 = 32 * nb;
    const float* src; int ld, col; mp(n0 + (lane & 31), src, ld, col);
    float vv[32];
#pragma unroll
    for (int i = 0; i < 32; ++i) { const int kk = 2 * i + (lane >> 5); vv[i] = src ? src[(size_t)(k0 + kk) * ld + col] : 0.f; }
#pragma unroll
    for (int i = 0; i < 32; ++i) { const int kk = 2 * i + (lane >> 5); float v = vv[i]; if (gain) v *= gain[k0 + kk]; scr[kk * 33 + (lane & 31)] = v; }
    asm volatile("s_waitcnt lgkmcnt(0)" ::: "memory");
    const int c = lane & 7;
#pragma unroll
    for (int j = 0; j < 4; ++j) { const int n = (lane >> 3) + 8 * j; const LAS float* s = scr + (8 * c) * 33 + n;
        u32x4 o; o.x = pk2(s[0 * 33], s[1 * 33]); o.y = pk2(s[2 * 33], s[3 * 33]); o.z = pk2(s[4 * 33], s[5 * 33]); o.w = pk2(s[6 * 33], s[7 * 33]);
        *(u32x4*)(WT + (size_t)(n0 + n) * K + k0 + 8 * c) = o; }
    asm volatile("s_waitcnt lgkmcnt(0)" ::: "memory");
}
__device__ __forceinline__ void convert_ffn_weights(const Params& p, int l, LAS unsigned char* lds, int gwave, int gwaves, int wave, int lane) {
    LAS float* scr = (LAS float*)(lds + wave * 16384);
    unsigned char* ws = WSP();
    constexpr int I_FI = (DM / 64) * (NFI / 32), I_FO = (FF / 64) * (DM / 32);
    const MapFfnIn mfi{INP(I_W_FFN_IN) + (size_t)l * DM * NFI}; const MapPlain mfo{INP(I_W_FFN_OUT) + (size_t)l * FF * DM, DM};
    for (int it = gwave; it < I_FI + I_FO; it += gwaves) {
        if (it < I_FI) transpose_item(mfi, DM, NFI / 32, (bf16_t*)(ws + WS_WFI), INP(I_FFN_NORM) + l * DM, scr, it, lane);
        else transpose_item(mfo, FF, DM / 32, (bf16_t*)(ws + WS_WFO), nullptr, scr, it - I_FI, lane);
    }
}
__device__ __forceinline__ void fuse_weights(LAS unsigned char* lds, int tid) {
    unsigned char* ws = WSP(); LAS float* As = (LAS float*)lds; LAS float* Bs = As + 64 * 33;
    for (int it = blockIdx.x; it < 448; it += gridDim.x) {
        const int l = it / 224, r_ = it - l * 224; const bool isq = r_ < 96; const int tt = isq ? r_ : r_ - 96, nj = isq ? 6 : 8, kt = tt / nj, jt = tt - kt * nj;
        const int R = isq ? 256 : 128, NU = isq ? 384 : 512, roff = isq ? 0 : 256;
        const float* win = INP(I_W_IN) + (size_t)l * DM * INW + (size_t)(kt * 64) * INW + roff;
        const float* g = isq ? INP(I_Q_NORM) + l * 256 : INP(I_KV_NORM) + l * 128;
        const float* wu = (isq ? INP(I_W_UQ) + (size_t)l * 256 * 384 : INP(I_W_UKV) + (size_t)l * 128 * 512) + jt * 64;
        float* o = (isq ? (float*)(ws + WS_WFQ) + (size_t)l * DM * 384 : (float*)(ws + WS_WFKV) + (size_t)l * DM * 512) + (size_t)(kt * 64) * NU + jt * 64;
        const int ty = tid >> 4, tx = tid & 15; float acc[2][4];
#pragma unroll
        for (int x = 0; x < 2; ++x)
#pragma unroll
            for (int y = 0; y < 4; ++y) acc[x][y] = 0.f;
        for (int r0 = 0; r0 < R; r0 += 32) {
            __syncthreads();
#pragma unroll
            for (int i = 0; i < 4; ++i) { const int e = tid + 512 * i, kk = e >> 5, rr = e & 31; As[kk * 33 + rr] = win[(size_t)kk * INW + r0 + rr] * g[r0 + rr]; }
#pragma unroll
            for (int i = 0; i < 4; ++i) { const int e = tid + 512 * i, rr = e >> 6, jj = e & 63; Bs[rr * 64 + jj] = wu[(size_t)(r0 + rr) * NU + jj]; }
            __syncthreads();
#pragma unroll 8
            for (int rr = 0; rr < 32; ++rr) { const float a0 = As[(2 * ty) * 33 + rr], a1 = As[(2 * ty + 1) * 33 + rr]; const f32x4 bv = *(const LAS f32x4*)(Bs + rr * 64 + 4 * tx);
#pragma unroll
                for (int y = 0; y < 4; ++y) { acc[0][y] += a0 * bv[y]; acc[1][y] += a1 * bv[y]; } }
        }
#pragma unroll
        for (int x = 0; x < 2; ++x) *(f32x4*)(o + (size_t)(2 * ty + x) * NU + 4 * tx) = (f32x4){acc[x][0], acc[x][1], acc[x][2], acc[x][3]};
    }
    __syncthreads();
}
__device__ __forceinline__ void prologue_a(const Params& p, int gtid, int gthreads, int gwave, int gwaves, int lane) {
    unsigned char* ws = WSP();
    { const float* x = INP(I_X); bf16_t* xbf = (bf16_t*)(ws + WS_XBF); float* ssx = (float*)(ws + WS_SSX);
      for (int r2 = gwave; r2 < T / 2; r2 += gwaves) { f32x4 v[2][4];
#pragma unroll
          for (int u = 0; u < 2; ++u) { const f32x4* xr = (const f32x4*)(x + (size_t)(2 * r2 + u) * DM) + lane;
#pragma unroll
              for (int j = 0; j < 4; ++j) v[u][j] = xr[64 * j]; }
#pragma unroll
          for (int u = 0; u < 2; ++u) { const int r = 2 * r2 + u; float s = 0.f;
#pragma unroll
              for (int j = 0; j < 4; ++j) s += sq4(v[u][j]);
              s = wave_sum(s);
              unsigned long long* o8 = (unsigned long long*)(xbf + (size_t)r * DM) + lane;
#pragma unroll
              for (int j = 0; j < 4; ++j) o8[64 * j] = (unsigned long long)pk2(v[u][j][0], v[u][j][1]) | ((unsigned long long)pk2(v[u][j][2], v[u][j][3]) << 32);
              if (lane < 4) ssx[(size_t)r * 4 + lane] = (lane == 0) ? s : 0.f; } } }
    { float* ra = (float*)(ws + WS_ROPEA); float* rm = (float*)(ws + WS_ROPEM);
      for (int idx = gtid; idx < S * 24; idx += gthreads) { const int s = idx / 24, j = idx - s * 24; const double f = (j < 16) ? exp(-13.122363377404328 * (double)(2 * j) / 32.0) : exp(-13.122363377404328 * (double)(2 * (j - 16)) / 16.0);
          double rv = (double)s * f * 0.15915494309189535; rv -= floor(rv); const float fr = (float)rv;
          const float c = __builtin_amdgcn_cosf(fr), sn = __builtin_amdgcn_sinf(fr);
          if (j < 16) { ra[s * 16 + j] = c; ra[S * 16 + s * 16 + j] = sn; } else { rm[s * 8 + (j - 16)] = c; rm[S * 8 + s * 8 + (j - 16)] = sn; } } }
}
__device__ __forceinline__ void prologue_b(const Params& p, LAS unsigned char* lds, int gwave, int gwaves, int wave, int lane) {
    LAS float* scr = (LAS float*)(lds + wave * 16384);
    unsigned char* ws = WSP();
    constexpr int I_IN = (DM / 64) * (NIN / 32), I_OUT = (DM / 64) * (DM / 32);
    for (int it = gwave; it < 2 * (I_IN + I_OUT); it += gwaves) {
        const int l = it / (I_IN + I_OUT), r = it - l * (I_IN + I_OUT);
        if (r < I_IN) { const MapIn mi{INP(I_W_IN) + (size_t)l * DM * INW, (const float*)(ws + WS_WFQ) + (size_t)l * DM * 384, (const float*)(ws + WS_WFKV) + (size_t)l * DM * 512};
            transpose_item(mi, DM, NIN / 32, (bf16_t*)(ws + WS_WIN) + (size_t)l * NIN * DM, INP(I_ATTN_NORM) + l * DM, scr, r, lane); }
        else { const MapPlain mo{INP(I_W_OUT) + (size_t)l * DM * DM, DM};
            transpose_item(mo, DM, DM / 32, (bf16_t*)(ws + WS_WOUT) + (size_t)l * DM * DM, nullptr, scr, r - I_IN, lane); }
    }
    convert_ffn_weights(p, 0, lds, gwave, gwaves, wave, lane);
}

typedef float f32x16 __attribute__((ext_vector_type(16)));
using pg8::bf16x8;
#define ZERO16(v) do { _Pragma("unroll") for (int i_ = 0; i_ < 16; ++i_) v[i_] = 0.f; } while (0)

__device__ __forceinline__ void mid_mla(const Params& p, int gtid, int gthreads) {
    unsigned char* ws = WSP();
    bf16_t* Qa = (bf16_t*)(ws + WS_QA); bf16_t* Ka = (bf16_t*)(ws + WS_KA); bf16_t* Vta = (bf16_t*)(ws + WS_VTA);
    const float* ssq = (const float*)(ws + WS_SSQ); const float* ssk = (const float*)(ws + WS_SSK); const float* kpga = (const float*)(ws + WS_KPGA);
    const float* rc = (const float*)(ws + WS_ROPEA); const float* rsn = rc + S * 16;
    for (int idx = gtid; idx < T * 4; idx += gthreads) {
        const int b = idx / (4 * S), s = idx & (S - 1), r = b * S + s;
        const float rq = __builtin_amdgcn_rsqf(sum4(*(const f32x4*)(ssq + (size_t)r * 4)) * (1.f / 256.f) + EPS) * C_MLA;
        const float rk = __builtin_amdgcn_rsqf(sum4(*(const f32x4*)(ssk + (size_t)r * 4)) * (1.f / 128.f) + EPS);
        u32x4* q = (u32x4*)(Qa + (size_t)idx * 96); u32x4* k = (u32x4*)(Ka + ka_off(idx >> 12, s, 0));
        u32x4 qv[8], kv[8];
#pragma unroll
        for (int c = 0; c < 8; ++c) { qv[c] = q[c]; kv[c] = k[32 * c]; }
#pragma unroll
        for (int c = 0; c < 8; ++c) { u32x4 w = qv[c];
            w.x = pk2(bflo(w.x) * rq, bfhi(w.x) * rq); w.y = pk2(bflo(w.y) * rq, bfhi(w.y) * rq); w.z = pk2(bflo(w.z) * rq, bfhi(w.z) * rq); w.w = pk2(bflo(w.w) * rq, bfhi(w.w) * rq); q[c] = w;
            u32x4 z = kv[c];
            z.x = pk2(bflo(z.x) * rk, bfhi(z.x) * rk); z.y = pk2(bflo(z.y) * rk, bfhi(z.y) * rk); z.z = pk2(bflo(z.z) * rk, bfhi(z.z) * rk); z.w = pk2(bflo(z.w) * rk, bfhi(z.w) * rk); k[32 * c] = z; }
#pragma unroll
        for (int c = 0; c < 2; ++c) {
            const u32x4 a = q[8 + c], bq = q[10 + c];
            const f32x4 c0 = *(const f32x4*)(rc + s * 16 + 8 * c), c1 = *(const f32x4*)(rc + s * 16 + 8 * c + 4), s0 = *(const f32x4*)(rsn + s * 16 + 8 * c), s1 = *(const f32x4*)(rsn + s * 16 + 8 * c + 4);
            const float x1[8] = {bflo(a.x), bfhi(a.x), bflo(a.y), bfhi(a.y), bflo(a.z), bfhi(a.z), bflo(a.w), bfhi(a.w)};
            const float x2[8] = {bflo(bq.x), bfhi(bq.x), bflo(bq.y), bfhi(bq.y), bflo(bq.z), bfhi(bq.z), bflo(bq.w), bfhi(bq.w)};
            const float cc[8] = {c0[0], c0[1], c0[2], c0[3], c1[0], c1[1], c1[2], c1[3]}; const float ss[8] = {s0[0], s0[1], s0[2], s0[3], s1[0], s1[1], s1[2], s1[3]};
            float o1[8], o2[8];
#pragma unroll
            for (int i = 0; i < 8; ++i) { o1[i] = (x1[i] * cc[i] - x2[i] * ss[i]) * rq; o2[i] = (x2[i] * cc[i] + x1[i] * ss[i]) * rq; }
            u32x4 w1, w2; w1.x = pk2(o1[0], o1[1]); w1.y = pk2(o1[2], o1[3]); w1.z = pk2(o1[4], o1[5]); w1.w = pk2(o1[6], o1[7]);
            w2.x = pk2(o2[0], o2[1]); w2.y = pk2(o2[2], o2[3]); w2.z = pk2(o2[4], o2[5]); w2.w = pk2(o2[6], o2[7]);
            q[8 + c] = w1; q[10 + c] = w2;
            const f32x4 ka = *(const f32x4*)(kpga + (size_t)r * 48 + 8 * c), kb = *(const f32x4*)(kpga + (size_t)r * 48 + 8 * c + 4), kc = *(const f32x4*)(kpga + (size_t)r * 48 + 16 + 8 * c), kd = *(const f32x4*)(kpga + (size_t)r * 48 + 16 + 8 * c + 4);
            const float y1[8] = {ka[0], ka[1], ka[2], ka[3], kb[0], kb[1], kb[2], kb[3]}; const float y2[8] = {kc[0], kc[1], kc[2], kc[3], kd[0], kd[1], kd[2], kd[3]};
            float e1[8], e2[8];
#pragma unroll
            for (int i = 0; i < 8; ++i) { e1[i] = y1[i] * cc[i] - y2[i] * ss[i]; e2[i] = y2[i] * cc[i] + y1[i] * ss[i]; }
            u32x4 v1, v2; v1.x = pk2(e1[0], e1[1]); v1.y = pk2(e1[2], e1[3]); v1.z = pk2(e1[4], e1[5]); v1.w = pk2(e1[6], e1[7]);
            v2.x = pk2(e2[0], e2[1]); v2.y = pk2(e2[2], e2[3]); v2.z = pk2(e2[4], e2[5]); v2.w = pk2(e2[6], e2[7]);
            k[32 * (8 + c)] = v1; k[32 * (10 + c)] = v2;
        }
    }
    for (int ci = gtid; ci < 16 * S * 8; ci += gthreads) {
        const int bh = ci >> 15, rem = ci & 32767, tile = rem >> 8, i256 = (rem >> 5) & 7, s16 = (i256 >> 1) & 1, hh = i256 & 1;
        const int tok = (bh >> 2) * S + tile * 32 + 16 * s16 + 4 * hh;
        float rk[8];
#pragma unroll
        for (int i = 0; i < 8; ++i) rk[i] = __builtin_amdgcn_rsqf(sum4(*(const f32x4*)(ssk + (size_t)(tok + 8 * (i >> 2) + (i & 3)) * 4)) * (1.f / 128.f) + EPS);
        u32x4* vp = (u32x4*)(Vta + (size_t)ci * 8); u32x4 w = *vp;
        w.x = pk2(bflo(w.x) * rk[0], bfhi(w.x) * rk[1]); w.y = pk2(bflo(w.y) * rk[2], bfhi(w.y) * rk[3]); w.z = pk2(bflo(w.z) * rk[4], bfhi(w.z) * rk[5]); w.w = pk2(bflo(w.w) * rk[6], bfhi(w.w) * rk[7]);
        *vp = w;
    }
}
__device__ __forceinline__ void mid_kmean(const Params& p, LAS unsigned char* lds, int tid) {
    const bf16_t* Km = (const bf16_t*)(WSP() + WS_KM); float* kmean = (float*)(WSP() + WS_KMEAN); LAS float* red = (LAS float*)lds;
    for (int it = blockIdx.x; it < 256; it += gridDim.x) {
        const int d = tid & 63, part = tid >> 6; const bf16_t* base = Km + km_off(it >> 4, (it & 15) * 256 + part * 32, d); float s = 0.f;
        for (int k = 0; k < 32; ++k) s += bf2f(base[k * 8]);
        red[part * 64 + d] = s; __syncthreads();
        if (tid < 64) { float t = 0.f;
#pragma unroll
            for (int q = 0; q < 8; ++q) t += red[q * 64 + tid];
            kmean[it * 64 + tid] = t * (1.f / 256.f); }
        __syncthreads();
    }
}
struct GlaLds { LAS float *alow, *sk, *sv, *sb; };
constexpr int GLA_HS = 16000;
__device__ __forceinline__ void gla_common(const Params& p, int l, int item, const GlaLds& L, int t) {
    const int h = item & 3, bn = item >> 2, r0 = bn * 64;
    const bf16_t* proj = (const bf16_t*)(WSP() + WS_PROJ); const float* kpga = (const float*)(WSP() + WS_KPGA);
    const float* wa2 = INP(I_GLA_WA2) + l * 16 * 128; const float* ba2 = INP(I_GLA_BA2) + l * 128;
    { const int tt = t >> 2, j4 = (t & 3) * 4; *(LAS f32x4*)(L.alow + tt * 16 + j4) = *(const f32x4*)(kpga + (size_t)(r0 + tt) * 48 + 32 + j4); }
    { const int tt = t >> 2, d8 = (t & 3) * 8; const u32x4 w = *(const u32x4*)(proj + (size_t)(r0 + tt) * NPJ + 128 + h * 32 + d8); LAS float* d = L.sk + tt * 33 + d8;
      d[0] = bflo(w.x); d[1] = bfhi(w.x); d[2] = bflo(w.y); d[3] = bfhi(w.y); d[4] = bflo(w.z); d[5] = bfhi(w.z); d[6] = bflo(w.w); d[7] = bfhi(w.w); }
#pragma unroll
    for (int i = 0; i < 2; ++i) { const int c = t + 256 * i, tt = c >> 3, d8 = (c & 7) * 8; const u32x4 w = *(const u32x4*)(proj + (size_t)(r0 + tt) * NPJ + 256 + h * 64 + d8); LAS float* d = L.sv + tt * 64 + d8;
      *(LAS f32x4*)d = (f32x4){bflo(w.x), bfhi(w.x), bflo(w.y), bfhi(w.y)}; *(LAS f32x4*)(d + 4) = (f32x4){bflo(w.z), bfhi(w.z), bflo(w.w), bfhi(w.w)}; }
    __syncthreads();
    for (int i = t; i < 64 * 32; i += 256) { const int tt = i >> 5, d = i & 31; float z = ba2[h * 32 + d];
#pragma unroll
        for (int j = 0; j < 16; ++j) z += L.alow[tt * 16 + j] * wa2[j * 128 + h * 32 + d];
        L.sb[tt * 33 + d] = logsigmoidf_(z) * (1.f / 16.f); }
    __syncthreads();
    { const int d = t & 31, sg = t >> 5;
      float v[8]; float c = 0.f;
#pragma unroll
      for (int k = 0; k < 8; ++k) { c += L.sb[(8 * sg + k) * 33 + d]; v[k] = c; }
      L.alow[sg * 32 + d] = c;
      __syncthreads();
      float off = 0.f;
      for (int s2 = 0; s2 < sg; ++s2) off += L.alow[s2 * 32 + d];
#pragma unroll
      for (int k = 0; k < 8; ++k) L.sb[(8 * sg + k) * 33 + d] = v[k] + off; }
    __syncthreads();
}
__device__ __forceinline__ float* sb_cache() { return (float*)(WSP() + WS_WFQ); }
__device__ __forceinline__ void gla_common_cached(int item, const GlaLds& L, int t) {
    const int h = item & 3, bn = item >> 2, r0 = bn * 64;
    const bf16_t* proj = (const bf16_t*)(WSP() + WS_PROJ); const float* sbc = sb_cache();
    { const int tt = t >> 2, d8 = (t & 3) * 8; const u32x4 w = *(const u32x4*)(proj + (size_t)(r0 + tt) * NPJ + 128 + h * 32 + d8); LAS float* d = L.sk + tt * 33 + d8;
      const f32x4 b0 = *(const f32x4*)(sbc + (size_t)(r0 + tt) * 128 + h * 32 + d8), b1 = *(const f32x4*)(sbc + (size_t)(r0 + tt) * 128 + h * 32 + d8 + 4); LAS float* e = L.sb + tt * 33 + d8;
      d[0] = bflo(w.x); d[1] = bfhi(w.x); d[2] = bflo(w.y); d[3] = bfhi(w.y); d[4] = bflo(w.z); d[5] = bfhi(w.z); d[6] = bflo(w.w); d[7] = bfhi(w.w);
      e[0] = b0[0]; e[1] = b0[1]; e[2] = b0[2]; e[3] = b0[3]; e[4] = b1[0]; e[5] = b1[1]; e[6] = b1[2]; e[7] = b1[3]; }
#pragma unroll
    for (int i = 0; i < 2; ++i) { const int c = t + 256 * i, tt = c >> 3, d8 = (c & 7) * 8; const u32x4 w = *(const u32x4*)(proj + (size_t)(r0 + tt) * NPJ + 256 + h * 64 + d8); LAS float* d = L.sv + tt * 64 + d8;
      *(LAS f32x4*)d = (f32x4){bflo(w.x), bfhi(w.x), bflo(w.y), bfhi(w.y)}; *(LAS f32x4*)(d + 4) = (f32x4){bflo(w.z), bfhi(w.z), bflo(w.w), bfhi(w.w)}; }
    __syncthreads();
}
__device__ __forceinline__ void mid_gla(const Params& p, int l, LAS unsigned char* lds, int tid) {
    const int hb = tid >> 8, t = tid & 255;
    LAS float* f = (LAS float*)lds + hb * GLA_HS; const GlaLds L{f, f + 1024, f + 1024 + 64 * 33, f + 1024 + 64 * 33 + 4096};
    float* gds = (float*)(WSP() + WS_GDS); float* gdec = (float*)(WSP() + WS_GDEC); float* sbc = sb_cache();
    for (int it2 = blockIdx.x; it2 < 512; it2 += gridDim.x) {
        const int item = it2 * 2 + hb;
        gla_common(p, l, item, L, t);
        const int h = item & 3, bn = item >> 2, b = bn >> 6, n = bn & 63, bh = b * 4 + h, r0 = bn * 64;
        { const int tt = t >> 2, d8 = (t & 3) * 8; float bv[8], bl[8];
#pragma unroll
          for (int e = 0; e < 8; ++e) { bv[e] = L.sb[tt * 33 + d8 + e]; bl[e] = L.sb[63 * 33 + d8 + e]; }
          *(f32x4*)(sbc + (size_t)(r0 + tt) * 128 + h * 32 + d8) = (f32x4){bv[0], bv[1], bv[2], bv[3]}; *(f32x4*)(sbc + (size_t)(r0 + tt) * 128 + h * 32 + d8 + 4) = (f32x4){bv[4], bv[5], bv[6], bv[7]};
#pragma unroll
          for (int e = 0; e < 8; ++e) L.sk[tt * 33 + d8 + e] *= __expf(bl[e] - bv[e]); }
        __syncthreads();
        { const int lane = tid & 63, wv = (tid >> 6) & 3, r = lane & 31, hf = lane >> 5;
          if (wv < 2) { const int v0 = 32 * wv; f32x16 D; ZERO16(D);
#pragma unroll
              for (int ks = 0; ks < 4; ++ks) { float fa[8], fb[8];
#pragma unroll
                  for (int e = 0; e < 8; ++e) { const int tt = 16 * ks + 8 * hf + e; fa[e] = L.sk[tt * 33 + r]; fb[e] = L.sv[tt * 64 + v0 + r]; }
                  u32x4 wa, wb; wa.x = cvt_pk_safe(fa[0], fa[1]); wa.y = cvt_pk_safe(fa[2], fa[3]); wa.z = cvt_pk_safe(fa[4], fa[5]); wa.w = cvt_pk_safe(fa[6], fa[7]);
                  wb.x = cvt_pk_safe(fb[0], fb[1]); wb.y = cvt_pk_safe(fb[2], fb[3]); wb.z = cvt_pk_safe(fb[4], fb[5]); wb.w = cvt_pk_safe(fb[6], fb[7]);
                  D = __builtin_amdgcn_mfma_f32_32x32x16_bf16(__builtin_bit_cast(bf16x8, wa), __builtin_bit_cast(bf16x8, wb), D, 0, 0, 0); }
              float* o = gds + (size_t)(bh * 64 + n) * 2048 + v0 + r;
#pragma unroll
              for (int i = 0; i < 16; ++i) o[((i & 3) + 8 * (i >> 2) + 4 * hf) * 64] = D[i]; } }
        if (t < 32) gdec[(bh * 64 + n) * 32 + t] = __expf(L.sb[63 * 33 + t]);
        __syncthreads();
    }
}
__device__ __forceinline__ float neg_expm1(float x) {
    if (x > -0.25f) { float q = 1.f / 720.f; q = q * x + 1.f / 120.f; q = q * x + 1.f / 24.f; q = q * x + 1.f / 6.f; q = q * x + 0.5f; q = q * x + 1.f; return -x * q; }
    return 1.f - __expf(x);
}
__device__ __forceinline__ void mid_lru(const Params& p, int l, LAS unsigned char* lds, int tid) {
    LAS float* sx = (LAS float*)lds; LAS float* sxc = sx + 35 * 256;
    const bf16_t* proj = (const bf16_t*)(WSP() + WS_PROJ);
    float* lra = (float*)(WSP() + WS_LRA); float* lru = (float*)(WSP() + WS_LRU); float* aggA = (float*)(WSP() + WS_AGGA); float* aggU = (float*)(WSP() + WS_AGGU);
    const float* cw = INP(I_CONV_W) + l * 4 * 256; const float* cb = INP(I_CONV_B) + l * 256;
    const float* wa = INP(I_LRU_WA) + l * 4 * 64 * 64; const float* wx = INP(I_LRU_WX) + l * 4 * 64 * 64;
    const float* ba = INP(I_LRU_BA) + l * 256; const float* bx = INP(I_LRU_BX) + l * 256; const float* lam = INP(I_LRU_LAM) + l * 256;
    for (int item = blockIdx.x; item < T / 32; item += gridDim.x) {
        const int r0 = item * 32, s0 = r0 & (S - 1);
        for (int i = tid; i < 35 * 32; i += 512) { const int t = i >> 5, c8 = (i & 31) * 8; const int sp = s0 + t - 3;
            u32x4 w = (u32x4){0u, 0u, 0u, 0u}; if (sp >= 0) w = *(const u32x4*)(proj + (size_t)(r0 + t - 3) * NPJ + 768 + c8);
            LAS float* d = sx + t * 256 + c8; d[0] = bflo(w.x); d[1] = bfhi(w.x); d[2] = bflo(w.y); d[3] = bfhi(w.y); d[4] = bflo(w.z); d[5] = bfhi(w.z); d[6] = bflo(w.w); d[7] = bfhi(w.w); }
        __syncthreads();
        for (int i = tid; i < 32 * 256; i += 512) { const int t = i >> 8, ch = i & 255; float a = cb[ch];
#pragma unroll
            for (int j = 0; j < 4; ++j) a += cw[j * 256 + ch] * sx[(t + j) * 256 + ch];
            sxc[i] = a; }
        __syncthreads();
        const int ch = tid & 255, half = tid >> 8, n = ch >> 6, d = ch & 63;
        f32x2 acc2[16];
#pragma unroll
        for (int t = 0; t < 16; ++t) acc2[t] = (f32x2){0.f, 0.f};
#pragma unroll 2
        for (int c0 = 0; c0 < 64; c0 += 8) { f32x2 w2[8];
#pragma unroll
            for (int cc = 0; cc < 8; ++cc) { w2[cc][0] = wa[(n * 64 + c0 + cc) * 64 + d]; w2[cc][1] = wx[(n * 64 + c0 + cc) * 64 + d]; }
#pragma unroll
            for (int t = 0; t < 16; ++t) { const f32x4 x0 = *(const LAS f32x4*)(sxc + (half * 16 + t) * 256 + n * 64 + c0), x1 = *(const LAS f32x4*)(sxc + (half * 16 + t) * 256 + n * 64 + c0 + 4);
#pragma unroll
                for (int cc = 0; cc < 4; ++cc) { acc2[t] += (f32x2){x0[cc], x0[cc]} * w2[cc]; acc2[t] += (f32x2){x1[cc], x1[cc]} * w2[4 + cc]; } } }
        float ar[16], ai[16];
#pragma unroll
        for (int t = 0; t < 16; ++t) { ar[t] = acc2[t][0]; ai[t] = acc2[t][1]; }
        const float lm = lam[ch], sp = fmaxf(-lm, 0.f) + __logf(1.f + __expf(-fabsf(lm)));
        const float b1 = ba[ch], b2 = bx[ch];
        float A = 1.f, U = 0.f;
#pragma unroll
        for (int t = 0; t < 16; ++t) {
            const float rr = sigmoidf_(ar[t] + b1), ig = sigmoidf_(ai[t] + b2);
            const float la = -8.f * rr * sp, a = __expf(la), mult = __builtin_amdgcn_sqrtf(neg_expm1(2.f * la));
            const float u = mult * ig * sxc[(half * 16 + t) * 256 + ch];
            const size_t o = (size_t)(r0 + half * 16 + t) * 256 + ch; lra[o] = a; lru[o] = u;
            A *= a; U = a * U + u;
        }
        const int b = r0 >> 12, c16 = (s0 >> 4) + half;
        aggA[((size_t)(b * 256 + ch)) * 256 + c16] = A; aggU[((size_t)(b * 256 + ch)) * 256 + c16] = U;
        __syncthreads();
    }
}

__device__ __forceinline__ void seq_scans(const Params& p, LAS unsigned char* lds, int tid, int gwave, int gwaves, int lane) {
    { float* gds = (float*)(WSP() + WS_GDS); const float* gdec = (const float*)(WSP() + WS_GDEC); LAS float* ex = (LAS float*)lds;
      for (int blk = blockIdx.x; blk < 256; blk += gridDim.x) {
          const int el = tid & 127, seg = tid >> 7, idx = blk * 128 + el, bh = idx >> 11, e = idx & 2047, dk = e >> 6;
          float* base = gds + (size_t)bh * 64 * 2048 + (size_t)(seg * 16) * 2048 + e; const float* dc = gdec + (bh * 64 + seg * 16) * 32 + dk;
          float ds[16], dd[16];
#pragma unroll
          for (int j = 0; j < 16; ++j) { ds[j] = base[(size_t)j * 2048]; dd[j] = dc[j * 32]; }
          float A = 1.f, U = 0.f;
#pragma unroll
          for (int j = 0; j < 16; ++j) { U = dd[j] * U + ds[j]; A *= dd[j]; }
          ex[(seg * 128 + el) * 2] = A; ex[(seg * 128 + el) * 2 + 1] = U;
          __syncthreads();
          float st = 0.f;
          for (int s2 = 0; s2 < seg; ++s2) st = ex[(s2 * 128 + el) * 2] * st + ex[(s2 * 128 + el) * 2 + 1];
#pragma unroll
          for (int j = 0; j < 16; ++j) { base[(size_t)j * 2048] = st; st = dd[j] * st + ds[j]; }
          __syncthreads();
      } }
    { const float* aggA = (const float*)(WSP() + WS_AGGA); const float* aggU = (const float*)(WSP() + WS_AGGU); float* carry = (float*)(WSP() + WS_CARRY);
      for (int it = gwave; it < 1024; it += gwaves) {
          const f32x4 a = *(const f32x4*)(aggA + (size_t)it * 256 + 4 * lane), u = *(const f32x4*)(aggU + (size_t)it * 256 + 4 * lane);
          float At = a[0], Ut = u[0];
#pragma unroll
          for (int k = 1; k < 4; ++k) { Ut = a[k] * Ut + u[k]; At = At * a[k]; }
#pragma unroll
          for (int off = 1; off < 64; off <<= 1) { const float Ao = __shfl_up(At, off), Uo = __shfl_up(Ut, off); if (lane >= off) { Ut = At * Uo + Ut; At = Ao * At; } }
          float hin = __shfl_up(Ut, 1); if (lane == 0) hin = 0.f;
          f32x4 c; c[0] = hin; c[1] = a[0] * c[0] + u[0]; c[2] = a[1] * c[1] + u[1]; c[3] = a[2] * c[2] + u[2];
          *(f32x4*)(carry + (size_t)it * 256 + 4 * lane) = c; } }
}
__device__ __forceinline__ size_t ka_off(int bh, int s, int d) { return (size_t)bh * S * 96 + (size_t)(s >> 5) * 3072 + (d >> 3) * 256 + (s & 31) * 8 + (d & 7); }
__device__ __forceinline__ size_t km_off(int bh, int s, int d) { return (size_t)bh * S * 64 + (size_t)(s >> 5) * 2048 + (d >> 3) * 256 + (s & 31) * 8 + (d & 7); }
__device__ __forceinline__ size_t vf_off(int bh, int key, int dv) { return (size_t)bh * S * 64 + (size_t)(key >> 5) * 2048 + ((((dv >> 5) * 2 + ((key >> 4) & 1)) * 2 + ((key >> 2) & 1)) * 256) + (dv & 31) * 8 + ((key >> 3) & 1) * 4 + (key & 3); }
template <int NKS> __device__ __forceinline__ void attn_load(const bf16_t* Kb, const bf16_t* Vb, int kt, int lane, bf16x8 (&kf)[NKS], bf16x8 (&vf)[4]) {
    const bf16_t* kp = Kb + (size_t)kt * (512 * NKS) + lane * 8; const bf16_t* vp = Vb + (size_t)kt * 2048 + lane * 8;
#pragma unroll
    for (int ks = 0; ks < NKS; ++ks) kf[ks] = *(const bf16x8*)(kp + ks * 512);
#pragma unroll
    for (int i = 0; i < 4; ++i) vf[i] = *(const bf16x8*)(vp + i * 512);
}
__device__ __forceinline__ float max3f_nop(float a, float b, float c) { float r; asm volatile("s_nop 15\n\ts_nop 3\n\tv_max3_f32 %0, %1, %2, %3" : "=v"(r) : "v"(a), "v"(b), "v"(c)); return r; }
__device__ __forceinline__ float max3f_(float a, float b, float c) { float r; asm volatile("v_max3_f32 %0, %1, %2, %3" : "=v"(r) : "v"(a), "v"(b), "v"(c)); return r; }
__device__ __forceinline__ float max2f_(float a, float b) { float r; asm volatile("v_max_f32_e32 %0, %1, %2" : "=v"(r) : "v"(a), "v"(b)); return r; }
template <int NKS> __device__ __forceinline__ void attn_tile(const bf16x8 (&kf)[NKS], const bf16x8 (&vf)[4], const bf16x8 (&qf)[NKS], bool diag, bool act, int r, int h, f32x16& O0, f32x16& O1, float& m, float& l) {
    f32x16 X;
#pragma unroll
    for (int i = 0; i < 16; ++i) X[i] = 0.f;
#pragma unroll
    for (int ks = 0; ks < NKS; ++ks) X = __builtin_amdgcn_mfma_f32_32x32x16_bf16(kf[ks], qf[ks], X, 0, 0, 0);
    if (diag) {
#pragma unroll
        for (int i = 0; i < 16; ++i) if ((i & 3) + 8 * (i >> 2) + 4 * h > r) X[i] = NEG_INF;
    }
    if (__ballot(!act) != 0ull) {
#pragma unroll
        for (int i = 0; i < 16; ++i) X[i] = act ? X[i] : NEG_INF;
    }
    float mx;
    { const float t0 = max3f_nop(X[0], X[1], X[2]), t1 = max3f_(X[3], X[4], X[5]), t2 = max3f_(X[6], X[7], X[8]), t3 = max3f_(X[9], X[10], X[11]), t4 = max3f_(X[12], X[13], X[14]);
      mx = max2f_(max3f_(t0, t1, X[15]), max3f_(t2, t3, t4)); }
    { const u32x2 pr = __builtin_amdgcn_permlane32_swap(__float_as_uint(mx), __float_as_uint(mx), false, false);
      mx = max2f_(__uint_as_float(pr[0]), __uint_as_float(pr[1])); }
    const float m_old = m; const float mn = max2f_(m, mx), ms = (mn == NEG_INF) ? 0.f : mn, al = __builtin_amdgcn_exp2f(m - ms); m = mn;
    f32x2 s2[4];
#pragma unroll
    for (int i = 0; i < 8; ++i) { const f32x2 d = (f32x2){X[2 * i], X[2 * i + 1]} - (f32x2){ms, ms}; X[2 * i] = __builtin_amdgcn_exp2f(d[0]); X[2 * i + 1] = __builtin_amdgcn_exp2f(d[1]); }
#pragma unroll
    for (int i = 0; i < 4; ++i) s2[i] = (f32x2){X[4 * i], X[4 * i + 1]} + (f32x2){X[4 * i + 2], X[4 * i + 3]};
    const f32x2 s1 = (s2[0] + s2[1]) + (s2[2] + s2[3]);
    const float ps = s1[0] + s1[1];
    l = l * al + ps;
    if (__ballot(mn != m_old) != 0ull) {
#pragma unroll
        for (int i = 0; i < 16; ++i) { O0[i] *= al; O1[i] *= al; }
    }
    bf16x8 p0, p1;
    { u32x4 w; w.x = cvt_pk_bf16(X[0], X[1]); w.y = cvt_pk_bf16(X[2], X[3]); w.z = cvt_pk_bf16(X[4], X[5]); w.w = cvt_pk_bf16(X[6], X[7]); p0 = __builtin_bit_cast(bf16x8, w);
      w.x = cvt_pk_bf16(X[8], X[9]); w.y = cvt_pk_bf16(X[10], X[11]); w.z = cvt_pk_bf16(X[12], X[13]); w.w = cvt_pk_bf16(X[14], X[15]); p1 = __builtin_bit_cast(bf16x8, w); }
    O0 = __builtin_amdgcn_mfma_f32_32x32x16_bf16(vf[0], p0, O0, 0, 0, 0);
    O0 = __builtin_amdgcn_mfma_f32_32x32x16_bf16(vf[1], p1, O0, 0, 0, 0);
    O1 = __builtin_amdgcn_mfma_f32_32x32x16_bf16(vf[2], p0, O1, 0, 0, 0);
    O1 = __builtin_amdgcn_mfma_f32_32x32x16_bf16(vf[3], p1, O1, 0, 0, 0);
}
__device__ __forceinline__ void attn_store(bf16_t* yrow, int h, const f32x16& O0, const f32x16& O1, float l) {
    const float inv = __builtin_amdgcn_rcpf(l + __shfl_xor(l, 32));
#pragma unroll
    for (int g = 0; g < 4; ++g) { u32x2 w; w.x = cvt_pk_bf16(O0[4 * g] * inv, O0[4 * g + 1] * inv); w.y = cvt_pk_bf16(O0[4 * g + 2] * inv, O0[4 * g + 3] * inv); *(u32x2*)(yrow + 8 * g + 4 * h) = w;
        u32x2 z; z.x = cvt_pk_bf16(O1[4 * g] * inv, O1[4 * g + 1] * inv); z.y = cvt_pk_bf16(O1[4 * g + 2] * inv, O1[4 * g + 3] * inv); *(u32x2*)(yrow + 32 + 8 * g + 4 * h) = z; }
}
__device__ __forceinline__ unsigned moba_select(const float* kmean_bh, const bf16x8 (&qf)[4], int blk, int h) {
    const float* kmean = kmean_bh + 8 * h;
    float g0 = NEG_INF, g1 = NEG_INF, g2 = NEG_INF; int i0 = -1, i1 = -1, i2 = -1;
    for (int jb = 0; jb < blk; ++jb) { float a = 0.f;
#pragma unroll
        for (int ks = 0; ks < 4; ++ks) { const f32x4 w0 = *(const f32x4*)(kmean + jb * 64 + 16 * ks), w1 = *(const f32x4*)(kmean + jb * 64 + 16 * ks + 4); const u32x4 qw = __builtin_bit_cast(u32x4, qf[ks]);
            a += bflo(qw.x) * w0[0] + bfhi(qw.x) * w0[1] + bflo(qw.y) * w0[2] + bfhi(qw.y) * w0[3] + bflo(qw.z) * w1[0] + bfhi(qw.z) * w1[1] + bflo(qw.w) * w1[2] + bfhi(qw.w) * w1[3]; }
        a += __shfl_xor(a, 32);
        if (a > g0) { g2 = g1; i2 = i1; g1 = g0; i1 = i0; g0 = a; i0 = jb; } else if (a > g1) { g2 = g1; i2 = i1; g1 = a; i1 = jb; } else if (a > g2) { g2 = a; i2 = jb; } }
    unsigned sel = 0u; if (i0 >= 0) sel |= 1u << i0; if (i1 >= 0) sel |= 1u << i1; if (i2 >= 0) sel |= 1u << i2;
    return sel;
}
template <int NKS, bool MOBA> __device__ __forceinline__ void attn_block(int bh, int qi, LAS unsigned char* lds, int tid, int wave, int lane) {
    unsigned char* ws = WSP(); const int r = lane & 31, h = lane >> 5, b = bh >> 2, hh = bh & 3, qt = 8 * qi + wave, q = qt * 32 + r;
    constexpr int DK = 16 * NKS, KCH = 64 * NKS  , TOT = KCH + 256;
    const bf16_t* Qp = (const bf16_t*)(ws + (MOBA ? WS_QM : WS_QA)) + ((size_t)bh * S + q) * DK + 8 * h;
    bf16x8 qf[NKS];
#pragma unroll
    for (int ks = 0; ks < NKS; ++ks) qf[ks] = *(const bf16x8*)(Qp + 16 * ks);
    unsigned sel = 0u;
    if (MOBA) sel = moba_select((const float*)(ws + WS_KMEAN) + (size_t)bh * 16 * 64, (const bf16x8 (&)[4])qf, qi, h);
    const bf16_t* Kb = (const bf16_t*)(ws + (MOBA ? WS_KM : WS_KA)) + (size_t)bh * S * DK; const bf16_t* Vb = (const bf16_t*)(ws + (MOBA ? WS_VTM : WS_VTA)) + (size_t)bh * S * 64;
    f32x16 O0, O1; ZERO16(O0); ZERO16(O1);
    float m = NEG_INF, l = 0.f;
    const int kt1 = 8 * qi + 8;
    const bool two = (tid + 512) < TOT;
    const int c0 = tid, c1 = two ? tid + 512 : tid + 512 - 256;
    const size_t off0 = (c0 < KCH) ? (size_t)c0 * 8 : (size_t)(c0 - KCH) * 8, off1 = (size_t)(c1 - KCH) * 8;
    const bf16_t* src0 = (c0 < KCH) ? Kb : Vb; const size_t tstep0 = (c0 < KCH) ? (size_t)(8 * KCH) : (size_t)2048;
    u32x4 g0, g1;
#define ATT_GLOAD(kt_) do { const int kc_ = ((kt_) < kt1) ? (kt_) : kt1 - 1; g0 = *(const u32x4*)(src0 + (size_t)kc_ * tstep0 + off0); g1 = *(const u32x4*)(Vb + (size_t)kc_ * 2048 + off1); } while (0)
#define ATT_LSTORE(buf_) do { *(LAS u32x4*)(lds + (buf_) * 16384 + c0 * 16) = g0; if (two) *(LAS u32x4*)(lds + (buf_) * 16384 + c1 * 16) = g1; } while (0)
    constexpr int NPFK = KCH / 8, NPF = NPFK + 32;
    unsigned pA = 0u, pB = 0u, pC = 0u, pD = 0u;
    const int pfl = tid % NPF; const char* pfsrc = (pfl < NPFK) ? (const char*)Kb + pfl * 128 : (const char*)Vb + (pfl - NPFK) * 128; const size_t pfstep = (pfl < NPFK) ? (size_t)(16 * KCH) : (size_t)4096;
#define ATT_PF(kt_, reg_) do { const int kc_ = ((kt_) < kt1) ? (kt_) : kt1 - 1; reg_ = *(const unsigned*)(pfsrc + (size_t)kc_ * pfstep); } while (0)
#define ATT_BAR() asm volatile("s_waitcnt lgkmcnt(0)\n\ts_barrier" ::: "memory")
#define ATT_STEP(kt_, reg_) do { const int kt = (kt_); const int cur = kt & 1; \
        asm volatile("" :: "v"(reg_)); \
        ATT_GLOAD(kt + 1); \
        ATT_PF(kt + 4, reg_); \
        bool act = true; \
        if (MOBA) { const int jb = kt >> 3; act = (jb == qi) || ((sel >> jb) & 1u); } \
        if (kt <= qt && __ballot(act) != 0ull) { \
            bf16x8 kf[NKS], vf[4]; const LAS unsigned char* base = lds + cur * 16384 + lane * 16; \
            _Pragma("unroll") for (int ks = 0; ks < NKS; ++ks) kf[ks] = *(const LAS bf16x8*)(base + ks * 1024); \
            _Pragma("unroll") for (int i = 0; i < 4; ++i) vf[i] = *(const LAS bf16x8*)(base + KCH * 16 + i * 1024); \
            attn_tile<NKS>(kf, vf, qf, kt == qt, act, r, h, O0, O1, m, l); \
        } \
        ATT_LSTORE(cur ^ 1); \
        ATT_BAR(); } while (0)
    __syncthreads();
    ATT_GLOAD(0); ATT_PF(1, pB); ATT_PF(2, pC); ATT_PF(3, pD); ATT_LSTORE(0);
    ATT_BAR();
    for (int kt4 = 0; kt4 < kt1; kt4 += 4) {
        ATT_STEP(kt4, pA); ATT_STEP(kt4 + 1, pB); ATT_STEP(kt4 + 2, pC); ATT_STEP(kt4 + 3, pD);
    }
    asm volatile("" :: "v"(pA), "v"(pB), "v"(pC), "v"(pD));
#undef ATT_PF
#undef ATT_BAR
#undef ATT_STEP
#undef ATT_GLOAD
#undef ATT_LSTORE
    attn_store((bf16_t*)(ws + WS_YCAT) + (size_t)(b * S + q) * DM + (MOBA ? 512 : 0) + hh * 64, h, O0, O1, l);
}

__device__ __forceinline__ void post_gla(const Params& p, int l, LAS unsigned char* lds, int tid) {
    const int hb = tid >> 8, t = tid & 255;
    LAS float* f = (LAS float*)lds + hb * GLA_HS; const GlaLds L{f, f + 1024, f + 1024 + 64 * 33, f + 1024 + 64 * 33 + 4096};
    LAS float* sqe = f + 1024 + 2 * 64 * 33 + 4096; LAS float* sqb = sqe + 64 * 33; LAS float* sst = sqb + 64 * 33; LAS float* srs = sst + 2048;
    const bf16_t* proj = (const bf16_t*)(WSP() + WS_PROJ); const float* gds = (const float*)(WSP() + WS_GDS); bf16_t* ycat = (bf16_t*)(WSP() + WS_YCAT);
    const float* hn = INP(I_GLA_HN) + l * 64;
    for (int it2 = blockIdx.x; it2 < 512; it2 += gridDim.x) {
        const int item = it2 * 2 + hb;
        gla_common_cached(item, L, t);
        const int h = item & 3, bn = item >> 2, b = bn >> 6, n = bn & 63, bh = b * 4 + h, r0 = bn * 64;
        { const int tt = t >> 2, d8 = (t & 3) * 8; const u32x4 w = *(const u32x4*)(proj + (size_t)(r0 + tt) * NPJ + h * 32 + d8);
          const float qv[8] = {bflo(w.x), bfhi(w.x), bflo(w.y), bfhi(w.y), bflo(w.z), bfhi(w.z), bflo(w.w), bfhi(w.w)};
#pragma unroll
          for (int e = 0; e < 8; ++e) { const int d = d8 + e; const float bb = L.sb[tt * 33 + d], br = 0.5f * L.sb[63 * 33 + d], q1 = qv[e] * 0.17677669529663687f;
              sqe[tt * 33 + d] = q1 * __expf(bb - br); sqb[tt * 33 + d] = q1 * __expf(bb); L.sk[tt * 33 + d] *= __expf(br - bb); } }
#pragma unroll
        for (int i = 0; i < 2; ++i) { const int c = t + 256 * i; *(LAS f32x4*)(sst + c * 4) = *(const f32x4*)(gds + (size_t)(bh * 64 + n) * 2048 + c * 4); }
        __syncthreads();
        f32x16 O; ZERO16(O);
        const int lane = tid & 63, wv = (tid >> 6) & 3, r = lane & 31, hf = lane >> 5, it = (wv >> 1) & 1, vt = wv & 1, i0 = 32 * it, v0 = 32 * vt;
        if (wv < 4) {
#define FRAG_ROW(dst, arr, rowstride, row, col0) do { float f_[8]; _Pragma("unroll") for (int e_ = 0; e_ < 8; ++e_) f_[e_] = arr[(row) * (rowstride) + (col0) + e_]; \
            u32x4 w_; w_.x = cvt_pk_safe(f_[0], f_[1]); w_.y = cvt_pk_safe(f_[2], f_[3]); w_.z = cvt_pk_safe(f_[4], f_[5]); w_.w = cvt_pk_safe(f_[6], f_[7]); dst = __builtin_bit_cast(bf16x8, w_); } while (0)
#define FRAG_COL(dst, arr, colstride, k0_, col) do { float f_[8]; _Pragma("unroll") for (int e_ = 0; e_ < 8; ++e_) f_[e_] = arr[((k0_) + 8 * (e_ >> 2) + (e_ & 3)) * (colstride) + (col)]; \
            u32x4 w_; w_.x = cvt_pk_safe(f_[0], f_[1]); w_.y = cvt_pk_safe(f_[2], f_[3]); w_.z = cvt_pk_safe(f_[4], f_[5]); w_.w = cvt_pk_safe(f_[6], f_[7]); dst = __builtin_bit_cast(bf16x8, w_); } while (0)
#pragma unroll
            for (int ks = 0; ks < 2; ++ks) { bf16x8 fa, fb; float f_[8];
#pragma unroll
                for (int e_ = 0; e_ < 8; ++e_) f_[e_] = sst[(16 * ks + 8 * hf + e_) * 64 + v0 + r];
                { u32x4 w_; w_.x = cvt_pk_safe(f_[0], f_[1]); w_.y = cvt_pk_safe(f_[2], f_[3]); w_.z = cvt_pk_safe(f_[4], f_[5]); w_.w = cvt_pk_safe(f_[6], f_[7]); fa = __builtin_bit_cast(bf16x8, w_); }
                FRAG_ROW(fb, sqb, 33, i0 + r, 16 * ks + 8 * hf);
                O = __builtin_amdgcn_mfma_f32_32x32x16_bf16(fa, fb, O, 0, 0, 0); }
            for (int jt = 0; jt <= it; ++jt) {
                f32x16 X; ZERO16(X);
#pragma unroll
                for (int ks = 0; ks < 2; ++ks) { bf16x8 fa, fb; FRAG_ROW(fa, L.sk, 33, 32 * jt + r, 16 * ks + 8 * hf); FRAG_ROW(fb, sqe, 33, i0 + r, 16 * ks + 8 * hf);
                    X = __builtin_amdgcn_mfma_f32_32x32x16_bf16(fa, fb, X, 0, 0, 0); }
                if (jt == it) {
#pragma unroll
                    for (int i = 0; i < 16; ++i) if ((i & 3) + 8 * (i >> 2) + 4 * hf > r) X[i] = 0.f;
                }
                bf16x8 p0, p1;
                { u32x4 w; w.x = cvt_pk_safe(X[0], X[1]); w.y = cvt_pk_safe(X[2], X[3]); w.z = cvt_pk_safe(X[4], X[5]); w.w = cvt_pk_safe(X[6], X[7]); p0 = __builtin_bit_cast(bf16x8, w);
                  w.x = cvt_pk_safe(X[8], X[9]); w.y = cvt_pk_safe(X[10], X[11]); w.z = cvt_pk_safe(X[12], X[13]); w.w = cvt_pk_safe(X[14], X[15]); p1 = __builtin_bit_cast(bf16x8, w); }
                bf16x8 va, vb; FRAG_COL(va, L.sv, 64, 32 * jt + 4 * hf, v0 + r); FRAG_COL(vb, L.sv, 64, 32 * jt + 16 + 4 * hf, v0 + r);
                O = __builtin_amdgcn_mfma_f32_32x32x16_bf16(va, p0, O, 0, 0, 0);
                O = __builtin_amdgcn_mfma_f32_32x32x16_bf16(vb, p1, O, 0, 0, 0);
            }
#undef FRAG_ROW
#undef FRAG_COL
            float ss = 0.f;
#pragma unroll
            for (int i = 0; i < 16; ++i) ss += O[i] * O[i];
            ss += __shfl_xor(ss, 32);
            if (hf == 0) srs[(it * 2 + vt) * 32 + r] = ss;
        }
        __syncthreads();
        if (wv < 4) {
            const float rs = __builtin_amdgcn_rsqf((srs[(it * 2) * 32 + r] + srs[(it * 2 + 1) * 32 + r]) * (1.f / 64.f) + EPS);
            const int row = r0 + i0 + r;
#pragma unroll
            for (int g4 = 0; g4 < 4; ++g4) { const int v = v0 + 8 * g4 + 4 * hf;
                const u32x2 gw = *(const u32x2*)(proj + (size_t)row * NPJ + 512 + h * 64 + v); const float g[4] = {bflo(gw.x), bfhi(gw.x), bflo(gw.y), bfhi(gw.y)};
                const f32x4 gn = *(const f32x4*)(hn + v); float y[4];
#pragma unroll
                for (int c = 0; c < 4; ++c) y[c] = O[4 * g4 + c] * rs * gn[c] * (g[c] * __builtin_amdgcn_rcpf(1.f + __expf(-g[c])));
                u32x2 w; w.x = cvt_pk_safe(y[0], y[1]); w.y = cvt_pk_safe(y[2], y[3]); *(u32x2*)(ycat + (size_t)row * DM + 256 + h * 64 + v) = w; }
        }
        __syncthreads();
    }
}
__device__ __forceinline__ void post_lru(const Params& p, int gtid, int gthreads) {
    const float* lra = (const float*)(WSP() + WS_LRA); const float* lru = (const float*)(WSP() + WS_LRU); const float* carry = (const float*)(WSP() + WS_CARRY);
    const bf16_t* proj = (const bf16_t*)(WSP() + WS_PROJ); bf16_t* ycat = (bf16_t*)(WSP() + WS_YCAT);
    for (int idx = gtid; idx < 4 * 256 * 256; idx += gthreads) {
        const int ch = idx & 255, c16 = (idx >> 8) & 255, b = idx >> 16; float hcur = carry[(size_t)(b * 256 + ch) * 256 + c16];
        const int r0 = b * S + c16 * 16;
        float av[16], uv[16], gv[16];
#pragma unroll
        for (int t = 0; t < 16; ++t) { const size_t o = (size_t)(r0 + t) * 256 + ch; av[t] = lra[o]; uv[t] = lru[o]; gv[t] = bf2f(proj[(size_t)(r0 + t) * NPJ + 1024 + ch]); }
#pragma unroll
        for (int t = 0; t < 16; ++t) { hcur = av[t] * hcur + uv[t]; ycat[(size_t)(r0 + t) * DM + 768 + ch] = (bf16_t)f2bf(hcur * gelu_tanh(gv[t])); }
    }
}
__device__ __forceinline__ void final_norm(const Params& p, int gwave, int gwaves, int lane) {
    float* out = OUTP(); const float* g = INP(I_FINAL_NORM);
    f32x4 gv[4];
#pragma unroll
    for (int j = 0; j < 4; ++j) gv[j] = ((const f32x4*)g)[64 * j + lane];
    for (int r2 = gwave; r2 < T / 2; r2 += gwaves) { f32x4 v[2][4];
#pragma unroll
        for (int u = 0; u < 2; ++u) { const f32x4* xr = (const f32x4*)(out + (size_t)(2 * r2 + u) * DM) + lane;
#pragma unroll
            for (int j = 0; j < 4; ++j) v[u][j] = xr[64 * j]; }
#pragma unroll
        for (int u = 0; u < 2; ++u) { f32x4* xr = (f32x4*)(out + (size_t)(2 * r2 + u) * DM) + lane; float s = 0.f;
#pragma unroll
            for (int j = 0; j < 4; ++j) s += sq4(v[u][j]);
            const float rs = __builtin_amdgcn_rsqf(wave_sum(s) * (1.f / 1024.f) + EPS);
#pragma unroll
            for (int j = 0; j < 4; ++j) xr[64 * j] = v[u][j] * rs * gv[j]; } }
}
#define TIDS int tid = threadIdx.x; asm volatile("" : "+v"(tid)); const int lane = tid & 63, wave = __builtin_amdgcn_readfirstlane(tid >> 6); \
    const int G = gridDim.x, gtid = blockIdx.x * 512 + tid, gthreads = G * 512, gwave = blockIdx.x * 8 + wave, gwaves = G * 8; (void)lane; (void)gtid; (void)gthreads; (void)gwave; (void)gwaves;
#ifdef DUP_SYNC
#define GSYNC() do { xcd_barrier(xbar); xcd_barrier(xbar); } while (0)
#else
#define GSYNC() xcd_barrier(xbar)
#endif
template <int l> __device__ __forceinline__ void layer_body(const Params& p, LAS unsigned char* lds, const XcdBarrier& xbar) {
#ifndef NO_P1
        { unsigned char* ws = WSP(); pg8::Gemm g{(const bf16_t*)(ws + WS_XBF), (const bf16_t*)(ws + WS_WIN) + (size_t)l * NIN * DM, T, NIN, DM}; pg8::StaticOrder so; so.init(T, NIN, (int)gridDim.x, (int)blockIdx.x);
          EpiIn E{ws};
          pg8::gemm_phase<EpiIn, pg8::StaticOrder, true, true>(lds, g, so, E);
#ifdef DUP_P1
          __syncthreads(); pg8::gemm_phase<EpiIn, pg8::StaticOrder, true, true>(lds, g, so, E);
#endif
        }
#endif
        GSYNC();
#ifndef NO_MID
        { TIDS; mid_mla(p, gtid, gthreads); mid_kmean(p, lds, tid); mid_gla(p, l, lds, tid); mid_lru(p, l, lds, tid); }
#ifdef DUP_MIDG
        { TIDS; mid_gla(p, l, lds, tid); }
#endif
#ifdef DUP_MIDL
        { TIDS; mid_lru(p, l, lds, tid); }
#endif
#endif
        if (l == 1) { TIDS; convert_ffn_weights(p, 1, lds, gwave, gwaves, wave, lane); }
        GSYNC();
        { TIDS; seq_scans(p, lds, tid, gwave, gwaves, lane);
          asm volatile("s_waitcnt vmcnt(0)" ::: "memory"); __syncthreads();
          if (tid == 0) { __builtin_amdgcn_fence(__ATOMIC_RELEASE, "agent"); asm volatile("s_waitcnt vmcnt(0)" ::: "memory");
                          __hip_atomic_fetch_add((unsigned*)(WSP() + WS_LRW + 36864) + 64 * l, 1u, __ATOMIC_RELAXED, __HIP_MEMORY_SCOPE_AGENT); }
#ifndef NO_ATT
          { const int x = blockIdx.x & 7, j = blockIdx.x >> 3, bh = 2 * x + (j & 1), qi = j >> 1;
            attn_block<6, false>(bh, qi, lds, tid, wave, lane); attn_block<4, true>(bh, 15 - qi, lds, tid, wave, lane);
#ifdef DUP_ATT
            attn_block<6, false>(bh, qi, lds, tid, wave, lane); attn_block<4, true>(bh, 15 - qi, lds, tid, wave, lane);
#endif
          }
#endif
          if (tid == 0) { unsigned sp = 0u; while (__hip_atomic_load((unsigned*)(WSP() + WS_LRW + 36864) + 64 * l, __ATOMIC_RELAXED, __HIP_MEMORY_SCOPE_AGENT) < gridDim.x) { __builtin_amdgcn_s_sleep(2); if (++sp > (1u << 22)) break; }
                          __builtin_amdgcn_fence(__ATOMIC_ACQUIRE, "agent"); asm volatile("s_waitcnt vmcnt(0)" ::: "memory"); }
          __syncthreads();
        }
#ifndef NO_POST
        { TIDS; post_gla(p, l, lds, tid); post_lru(p, gtid, gthreads); }
#ifdef DUP_POST
        { TIDS; post_gla(p, l, lds, tid); post_lru(p, gtid, gthreads); }
#endif
#endif
        GSYNC();
#ifndef NO_P5
        { unsigned char* ws = WSP(); pg8::Gemm g{(const bf16_t*)(ws + WS_YCAT), (const bf16_t*)(ws + WS_WOUT) + (size_t)l * DM * DM, T, DM, DM}; pg8::StaticOrder so; so.init(T, DM, (int)gridDim.x, (int)blockIdx.x);
          EpiRes E{(l == 0) ? INP(I_X) : (const float*)OUTP(), OUTP(), ws};
          pg8::gemm_phase<EpiRes, pg8::StaticOrder, true, true>(lds, g, so, E); }
#endif
        GSYNC();
#ifndef NO_P6
        { unsigned char* ws = WSP(); pg8::Gemm g{(const bf16_t*)(ws + WS_XBF), (const bf16_t*)(ws + WS_WFI), T, NFI, DM}; pg8::StaticOrder so; so.init(T, NFI, (int)gridDim.x, (int)blockIdx.x);
          EpiSwi E{ws};
          pg8::gemm_phase<EpiSwi, pg8::StaticOrder, true, true>(lds, g, so, E);
#ifdef DUP_P6
          __syncthreads(); pg8::gemm_phase<EpiSwi, pg8::StaticOrder, true, true>(lds, g, so, E);
#endif
        }
#endif
        GSYNC();
#ifndef NO_P7
        { unsigned char* ws = WSP(); pg8::Gemm g{(const bf16_t*)(ws + WS_ACT), (const bf16_t*)(ws + WS_WFO), T, DM, FF}; pg8::StaticOrder so; so.init(T, DM, (int)gridDim.x, (int)blockIdx.x);
          if (l == 1) { EpiResFinal E{(const float*)OUTP(), OUTP(), INP(I_FINAL_NORM), (float*)(ws + WS_SSX), (unsigned*)(ws + WS_LRW + 16384)};
                        pg8::gemm_phase<EpiResFinal, pg8::StaticOrder, true, true>(lds, g, so, E); }
          else { EpiRes E{(const float*)OUTP(), OUTP(), ws};
                 pg8::gemm_phase<EpiRes, pg8::StaticOrder, true, true>(lds, g, so, E); } }
#endif
        if (l == 0) GSYNC();
    }
__global__ void __launch_bounds__(512) mega_fwd(Params p) {
    extern __shared__ __attribute__((aligned(16))) unsigned char lds_raw[];
    LAS unsigned char* lds = (LAS unsigned char*)lds_raw;
    cg::grid_group grid = cg::this_grid();
    (void)p;
    if (threadIdx.x < 4) ((volatile LAS unsigned*)(lds + 131072))[threadIdx.x] = 0u;
    __syncthreads();
    const XcdBarrier xbar = xcd_barrier_post((unsigned*)(WSP() + WS_LRW), (volatile LAS unsigned*)(lds + 131072));
    { TIDS; fuse_weights(lds, tid); }
    { TIDS; prologue_a(p, gtid, gthreads, gwave, gwaves, lane); }
    if (gridDim.x == 0x7fffffffu) grid.sync();
    GSYNC();
    { TIDS; prologue_b(p, lds, gwave, gwaves, wave, lane); }
    GSYNC();
#ifdef DUP_PRO
    { TIDS; prologue_a(p, gtid, gthreads, gwave, gwaves, lane); }
    GSYNC();
    { TIDS; prologue_b(p, lds, gwave, gwaves, wave, lane); }
    GSYNC();
#endif
    layer_body<0>(p, lds, xbar);
    layer_body<1>(p, lds, xbar);
}
}

extern "C" void kernel_launch(void* const* d_in, const int* in_sizes, int n_in, void* d_out, int out_size, void* d_ws, size_t ws_size, hipStream_t stream) {
    static int grid = 0;
    if (grid == 0) {
        if (n_in != 22 || ws_size < mk::WS_END) { fprintf(stderr, "kernel_launch: unexpected inputs (n_in %d, ws %zu)\n", n_in, ws_size); grid = -1; return; }
        int dev = 0, cus = 0, per_cu = 0;
        hipGetDevice(&dev); hipDeviceGetAttribute(&cus, hipDeviceAttributeMultiprocessorCount, dev);
        if (hipFuncSetAttribute((const void*)mk::mega_fwd, hipFuncAttributeMaxDynamicSharedMemorySize, mk::LDS_BYTES) != hipSuccess) { fprintf(stderr, "kernel_launch: hipFuncSetAttribute failed\n"); grid = -1; return; }
        if (hipOccupancyMaxActiveBlocksPerMultiprocessor(&per_cu, (const void*)mk::mega_fwd, 512, mk::LDS_BYTES) != hipSuccess || per_cu < 1) per_cu = 1;
        (void)hipGetLastError();
        grid = cus * per_cu;
        if (grid != 256) { fprintf(stderr, "kernel_launch: this kernel needs a 256-workgroup grid (got %d)\n", grid); grid = -1; return; }
    }
    if (grid < 0) return;
    mk::Params p{};
    for (int i = 0; i < 22; ++i) p.in[i] = (const float*)d_in[i];
    p.out = (float*)d_out; p.ws = (unsigned char*)d_ws;
    if (hipMemsetAsync((char*)d_ws + mk::WS_LRW, 0, 49152, stream) != hipSuccess) { fprintf(stderr, "kernel_launch: memset of the barrier words failed\n"); return; }
    void* args[] = {&p};
    hipError_t e = hipLaunchCooperativeKernel((const void*)mk::mega_fwd, dim3(grid), dim3(512), args, mk::LDS_BYTES, stream);
    if (e != hipSuccess) fprintf(stderr, "cooperative launch failed: %s (grid %d)\n", hipGetErrorString(e), grid);
}
```

```cpp
#include <hip/hip_runtime.h>
#include <hip/hip_cooperative_groups.h>
#include <cstdio>
#include <cstdint>
#include <cmath>
namespace cg = cooperative_groups;
namespace pg8 {
#define PG8_LAS __attribute__((address_space(3)))
typedef unsigned short bf16_t;
typedef short bf16x8 __attribute__((ext_vector_type(8)));
typedef float f32x4 __attribute__((ext_vector_type(4)));
typedef unsigned u32x4 __attribute__((ext_vector_type(4)));
constexpr int BM = 256, BK = 64, HALF = 128, HTB = HALF * BK * 2  , STAGE_BYTES = 8 * HTB, NXCD = 8, WGM = 3;

__host__ __device__ __forceinline__ int lds_byte(int r, int c) { const int st = (r >> 4) * 2 + (c >> 5), rr = r & 15, cc = c & 31, ob = rr * 64 + cc * 2; return st * 1024 + (ob ^ (((ob >> 9) & 1) << 5)); }
__host__ __device__ __forceinline__ void stage_rc(int b, int& R, int& C) { const int st = b / 1024, sb = b % 1024, swz = sb ^ (((sb >> 9) & 1) << 5); R = (st >> 1) * 16 + swz / 64; C = (st & 1) * 32 + (swz % 64) / 2; }
__host__ __device__ __forceinline__ int perm32(int rho) { const int n = rho >> 4, i = rho & 15; return 8 * (i >> 2) + 4 * n + (i & 3); }

struct Unit { int pm, pn; };
struct Gemm { const bf16_t* A; const bf16_t* Bt; int M, N, K; };

struct StaticOrder {
    int nM, nN, nwg, G, c;
    __host__ __device__ void init(int M, int N, int G_, int c_) { nM = M / BM; nN = N / BM; nwg = nM * nN; G = G_; c = c_; }
    __host__ __device__ bool next(int i, Unit& u) const {
        const long L = (long)i * G + c; if (L >= nwg) return false;
        int wgid = (int)L; { const int q = nwg / NXCD, r = nwg % NXCD, xcd = wgid % NXCD, off = wgid / NXCD; wgid = (xcd < r ? xcd * (q + 1) : r * (q + 1) + (xcd - r) * q) + off; }
        const int nig = WGM * nN, gid = wgid / nig, fm = gid * WGM, gsz = (nM - fm) < WGM ? (nM - fm) : WGM;
        u.pm = fm + ((wgid % nig) % gsz); u.pn = (wgid % nig) / gsz; return true;
    }
    __device__ __forceinline__ void a_ready(const Unit&) const {}
    __device__ __forceinline__ void done(const Unit&) const {}
};

__device__ __forceinline__ unsigned cvt_pk_bf16(float lo, float hi) { unsigned r; asm volatile("v_cvt_pk_bf16_f32 %0, %1, %2" : "=v"(r) : "v"(lo), "v"(hi)); return r; }
template <class Epi, class Sched, bool ALIGN_EPI = false, bool SP2 = false>
__device__ __forceinline__ void gemm_phase(PG8_LAS unsigned char* lds, const Gemm g, const Sched& S, const Epi& E) {
    int tid_ = threadIdx.x; asm volatile("" : "+v"(tid_));
    const int tid = tid_, wid = __builtin_amdgcn_readfirstlane(tid >> 6), lane = tid & 63, wr = wid >> 2, wc = wid & 3, fr = lane & 15, fq = lane >> 4;
    const int K = g.K, nt = K / BK;
    unsigned voffA[2], voffB[2];
#pragma unroll
    for (int i = 0; i < 2; ++i) { int R, C; stage_rc(tid * 16 + i * 8192, R, C); const int Rb = Epi::PERM ? ((R & ~31) + perm32(R & 31)) : R;
        voffA[i] = (unsigned)(R * K + C) * 2u; voffB[i] = (unsigned)(Rb * K + C) * 2u; }
    const size_t kstep = (size_t)(BK * 2);
    const size_t hstep = (size_t)HALF * K * 2;
    const size_t tstep = 2 * hstep;
    const unsigned ldsw = (unsigned)wid * 1024u;
    const int aoff = lds_byte(wr * 64 + fr, fq * 8), boff = lds_byte(wc * 32 + fr, fq * 8);
#define PG8_SA(b, h) (((b) * 2 + (h)) * HTB)
#define PG8_SB(b, h) ((4 + (b) * 2 + (h)) * HTB)
#define PG8_STAGE(bufoff, gbase, voff) do { _Pragma("unroll") for (int _i = 0; _i < 2; ++_i) \
        __builtin_amdgcn_global_load_lds((const unsigned*)((const char*)(gbase) + (voff)[_i]), (PG8_LAS unsigned*)(lds + (bufoff) + ldsw + _i * 8192), 16, 0, 0); } while (0)
#define PG8_LDA(dst, b, h) do { _Pragma("unroll") for (int m = 0; m < 4; ++m) _Pragma("unroll") for (int k = 0; k < 2; ++k) dst[m][k] = *(const PG8_LAS bf16x8*)(lds + PG8_SA(b, h) + aoff + m * 2048 + k * 1024); } while (0)
#define PG8_LDB(dst, b, h) do { _Pragma("unroll") for (int n = 0; n < 2; ++n) _Pragma("unroll") for (int k = 0; k < 2; ++k) dst[n][k] = *(const PG8_LAS bf16x8*)(lds + PG8_SB(b, h) + boff + n * 2048 + k * 1024); } while (0)
#define PG8_MMA(ai, bj, At, Bt) do { __builtin_amdgcn_s_setprio(1); _Pragma("unroll") for (int m = 0; m < 4; ++m) _Pragma("unroll") for (int n = 0; n < 2; ++n) _Pragma("unroll") for (int k = 0; k < 2; ++k) \
        acc[ai][bj][m][n] = __builtin_amdgcn_mfma_f32_16x16x32_bf16(Bt[n][k], At[m][k], acc[ai][bj][m][n], 0, 0, 0); __builtin_amdgcn_s_setprio(0); } while (0)
#define PG8_WAIT_V(n) asm volatile("s_waitcnt vmcnt(" #n ")" ::: "memory")
#define PG8_WAIT_L(n) asm volatile("s_waitcnt lgkmcnt(" #n ")" ::: "memory")
#define PG8_BAR __builtin_amdgcn_s_barrier()
#define PG8_SCHED __builtin_amdgcn_sched_barrier(0)
    Unit cur, nxt; int ui = 0;
    if (!S.next(0, cur)) return;
    f32x4 acc[2][2][4][2];
#pragma unroll
    for (int a = 0; a < 2; ++a)
#pragma unroll
        for (int b = 0; b < 2; ++b)
#pragma unroll
            for (int m = 0; m < 4; ++m)
#pragma unroll
                for (int n = 0; n < 2; ++n) acc[a][b][m][n] = (f32x4){0.f, 0.f, 0.f, 0.f};
    bf16x8 At[4][2], B0[2][2], B1[2][2];
    const char* cA = (const char*)g.A + (size_t)cur.pm * tstep; const char* cB = (const char*)g.Bt + (size_t)cur.pn * tstep;
    S.a_ready(cur);
    if constexpr (SP2) {
        PG8_STAGE(PG8_SB(0, 0), cB, voffB); PG8_STAGE(PG8_SB(0, 1), cB + hstep, voffB); PG8_STAGE(PG8_SA(0, 0), cA, voffA); PG8_STAGE(PG8_SA(0, 1), cA + hstep, voffA);
        if (wr == 1) PG8_BAR;
        PG8_WAIT_V(2); PG8_BAR;
        PG8_STAGE(PG8_SB(1, 0), cB + kstep, voffB); PG8_STAGE(PG8_SA(1, 0), cA + kstep, voffA); PG8_STAGE(PG8_SB(1, 1), cB + hstep + kstep, voffB);
        PG8_WAIT_V(6); PG8_BAR;
    } else {
        PG8_STAGE(PG8_SB(0, 0), cB, voffB); PG8_STAGE(PG8_SA(0, 0), cA, voffA); PG8_STAGE(PG8_SB(0, 1), cB + hstep, voffB); PG8_STAGE(PG8_SA(0, 1), cA + hstep, voffA);
        if (wr == 1) PG8_BAR;
        PG8_WAIT_V(4); PG8_BAR;
        PG8_STAGE(PG8_SB(1, 0), cB + kstep, voffB); PG8_STAGE(PG8_SA(1, 0), cA + kstep, voffA); PG8_STAGE(PG8_SB(1, 1), cB + hstep + kstep, voffB);
        PG8_WAIT_V(6); PG8_BAR;
    }
    for (;;) {
        const bool has_next = S.next(ui + 1, nxt);
        const char* nA = has_next ? (const char*)g.A + (size_t)nxt.pm * tstep : cA; const char* nB = has_next ? (const char*)g.Bt + (size_t)nxt.pn * tstep : cB;
        for (int t = 0; t < nt; t += 2) {
            const bool last = (t == nt - 2);
            const char* a1 = cA + (size_t)(t + 1) * kstep;
            const char* a2 = last ? nA : cA + (size_t)(t + 2) * kstep; const char* b2 = last ? nB : cB + (size_t)(t + 2) * kstep;
            const char* a3 = a2 + kstep; const char* b3 = b2 + kstep;
            if (last && has_next) S.a_ready(nxt);
            if constexpr (SP2) {
            PG8_LDB(B0, 0, 0); PG8_LDB(B1, 0, 1); PG8_SCHED; PG8_LDA(At, 0, 0); PG8_STAGE(PG8_SA(1, 1), a1 + hstep, voffA);
            PG8_WAIT_V(8); PG8_WAIT_L(0); PG8_BAR; PG8_MMA(0, 0, At, B0); PG8_MMA(0, 1, At, B1); PG8_BAR; PG8_SCHED;
            PG8_LDA(At, 0, 1); PG8_STAGE(PG8_SB(0, 0), b2, voffB); PG8_STAGE(PG8_SB(0, 1), b2 + hstep, voffB); PG8_STAGE(PG8_SA(0, 0), a2, voffA);
            PG8_WAIT_V(8); PG8_WAIT_L(0); PG8_BAR; PG8_MMA(1, 0, At, B0); PG8_MMA(1, 1, At, B1); PG8_BAR; PG8_SCHED;
            PG8_LDB(B0, 1, 0); PG8_LDB(B1, 1, 1); PG8_SCHED; PG8_LDA(At, 1, 0); PG8_STAGE(PG8_SA(0, 1), a2 + hstep, voffA);
            PG8_WAIT_V(8); PG8_WAIT_L(0); PG8_BAR; PG8_MMA(0, 0, At, B0); PG8_MMA(0, 1, At, B1); PG8_BAR; PG8_SCHED;
            PG8_LDA(At, 1, 1); PG8_STAGE(PG8_SB(1, 0), b3, voffB); PG8_STAGE(PG8_SB(1, 1), b3 + hstep, voffB); PG8_STAGE(PG8_SA(1, 0), a3, voffA);
            PG8_WAIT_V(8); PG8_WAIT_L(0); PG8_BAR; PG8_MMA(1, 0, At, B0); PG8_MMA(1, 1, At, B1); PG8_BAR; PG8_SCHED;
            } else {
            PG8_LDB(B0, 0, 0); PG8_SCHED; PG8_LDA(At, 0, 0); PG8_STAGE(PG8_SA(1, 1), a1 + hstep, voffA);
            PG8_WAIT_L(8); PG8_BAR; PG8_WAIT_L(0); PG8_MMA(0, 0, At, B0); PG8_BAR; PG8_SCHED;
            PG8_LDB(B1, 0, 1); PG8_STAGE(PG8_SB(0, 0), b2, voffB);
            PG8_BAR; PG8_WAIT_L(0); PG8_MMA(0, 1, At, B1); PG8_BAR;
            PG8_LDA(At, 0, 1); PG8_STAGE(PG8_SA(0, 0), a2, voffA);
            PG8_BAR; PG8_WAIT_L(0); PG8_MMA(1, 0, At, B0); PG8_BAR; PG8_SCHED;
            PG8_STAGE(PG8_SB(0, 1), b2 + hstep, voffB);
            PG8_WAIT_V(6); PG8_BAR; PG8_MMA(1, 1, At, B1); PG8_BAR;
            PG8_LDB(B0, 1, 0); PG8_SCHED; PG8_LDA(At, 1, 0); PG8_STAGE(PG8_SA(0, 1), a2 + hstep, voffA);
            PG8_WAIT_L(8); PG8_BAR; PG8_WAIT_L(0); PG8_MMA(0, 0, At, B0); PG8_BAR; PG8_SCHED;
            PG8_LDB(B1, 1, 1); PG8_STAGE(PG8_SB(1, 0), b3, voffB);
            PG8_BAR; PG8_WAIT_L(0); PG8_MMA(0, 1, At, B1); PG8_BAR;
            PG8_LDA(At, 1, 1); PG8_STAGE(PG8_SA(1, 0), a3, voffA);
            PG8_BAR; PG8_WAIT_L(0); PG8_MMA(1, 0, At, B0); PG8_BAR; PG8_SCHED;
            PG8_STAGE(PG8_SB(1, 1), b3 + hstep, voffB);
            PG8_WAIT_V(6); PG8_BAR; PG8_MMA(1, 1, At, B1); PG8_BAR;
            }
        }
        if constexpr (ALIGN_EPI) { if (wr == 0) PG8_BAR; }
        if constexpr (!Epi::AFTER_DRAIN) { E(acc, cur, wr, wc, fr, fq); S.done(cur); }
        if (!has_next) break;
#pragma unroll
        for (int a = 0; a < 2; ++a)
#pragma unroll
            for (int b = 0; b < 2; ++b)
#pragma unroll
                for (int m = 0; m < 4; ++m)
#pragma unroll
                    for (int n = 0; n < 2; ++n) acc[a][b][m][n] = (f32x4){0.f, 0.f, 0.f, 0.f};
        cur = nxt; cA = nA; cB = nB; ++ui;
        if constexpr (ALIGN_EPI) { if (wr == 1) PG8_BAR; }
    }
    PG8_WAIT_V(0);
    if constexpr (!ALIGN_EPI) { if (wr == 0) PG8_BAR; }
    PG8_BAR;
    if constexpr (Epi::AFTER_DRAIN) { E.fused(acc, cur, wr, wc, fr, fq, lds, wid, lane); S.done(cur); }
#undef PG8_SA
#undef PG8_SB
#undef PG8_STAGE
#undef PG8_LDA
#undef PG8_LDB
#undef PG8_MMA
#undef PG8_WAIT_V
#undef PG8_WAIT_L
#undef PG8_BAR
#undef PG8_SCHED
}
}

namespace mk {
#define LAS __attribute__((address_space(3)))
using pg8::f32x4; using pg8::u32x4; using pg8::bf16_t; using pg8::Unit; using pg8::cvt_pk_bf16;
typedef float f32x2 __attribute__((ext_vector_type(2)));
typedef unsigned u32x2 __attribute__((ext_vector_type(2)));

constexpr int T = 16384, S = 4096, DM = 1024, NIN = 3584, NPJ = 1280, FF = 2816, NFI = 5632, INW = 2480;
constexpr float EPS = 1e-6f;
constexpr float LOG2E = 1.4426950408889634f;
constexpr float C_MLA = 0.10206207261596577f * LOG2E;
constexpr float C_MOBA = 0.125f * LOG2E;
constexpr float NEG_INF = -INFINITY;

constexpr size_t MiB = 1u << 20, KiB = 1024;
constexpr size_t WS_SSX = 0, WS_SSQ = 1 * MiB, WS_SSK = 1 * MiB + 256 * KiB, WS_KPGA = 1 * MiB + 512 * KiB, WS_ROPEA = 4 * MiB + 512 * KiB,
                 WS_ROPEM = 5 * MiB, WS_KMEAN = 5 * MiB + 256 * KiB, WS_GDEC = 5 * MiB + 512 * KiB, WS_AGGA = 6 * MiB, WS_AGGU = 7 * MiB, WS_CARRY = 8 * MiB,
                 WS_LRW = 9 * MiB,
                 WS_WIN = 10 * MiB, WS_WOUT = 24 * MiB, WS_WFI = 28 * MiB, WS_WFO = 39 * MiB, WS_XBF = 45 * MiB, WS_YCAT = 77 * MiB, WS_GDS = 109 * MiB,
                 WS_LRA = 117 * MiB, WS_LRU = 133 * MiB, WS_ACT = 149 * MiB, WS_PROJ = 149 * MiB, WS_QA = 189 * MiB, WS_KA = 201 * MiB, WS_VTA = 213 * MiB,
                 WS_QM = 221 * MiB, WS_KM = 229 * MiB, WS_VTM = 237 * MiB, WS_WFQ = 245 * MiB, WS_WFKV = 248 * MiB, WS_END = 254 * MiB;
constexpr int LDS_BYTES = 147456;

struct Params { const float* in[22]; float* out; unsigned char* ws; };
enum { I_X = 0, I_ATTN_NORM, I_W_IN, I_Q_NORM, I_W_UQ, I_KV_NORM, I_W_UKV, I_GLA_WA2, I_GLA_BA2, I_GLA_HN, I_CONV_W, I_CONV_B, I_LRU_WA, I_LRU_BA, I_LRU_WX, I_LRU_BX,
       I_LRU_LAM, I_W_OUT, I_FFN_NORM, I_W_FFN_IN, I_W_FFN_OUT, I_FINAL_NORM };

#define CAS __attribute__((address_space(4)))
__device__ __forceinline__ const float* INP(int i) { const CAS char* ka = (const CAS char*)__builtin_amdgcn_kernarg_segment_ptr(); asm volatile("" : "+s"(ka)); return *(const float* const CAS*)(ka + 8 * i); }
__device__ __forceinline__ float* OUTP() { return (float*)INP(22); }
__device__ __forceinline__ unsigned char* WSP() { return (unsigned char*)INP(23); }

__device__ __forceinline__ float bf2f(unsigned h) { return __uint_as_float(h << 16); }
__device__ __forceinline__ float bflo(unsigned w) { return __uint_as_float(w << 16); }
__device__ __forceinline__ float bfhi(unsigned w) { return __uint_as_float(w & 0xffff0000u); }

__device__ __forceinline__ float wave_sum(float v) {
#pragma unroll
    for (int o = 1; o < 64; o <<= 1) v += __shfl_xor(v, o);
    return v;
}
__device__ __forceinline__ float sigmoidf_(float z) { return __builtin_amdgcn_rcpf(1.f + __expf(-z)); }
__device__ __forceinline__ float logsigmoidf_(float z) { return fminf(z, 0.f) - __logf(1.f + __expf(-fabsf(z))); }
__device__ __forceinline__ float gelu_tanh(float x) { const float u = 0.7978845608028654f * (x + 0.044715f * x * x * x); const float t = 1.f - 2.f * __builtin_amdgcn_rcpf(__expf(2.f * u) + 1.f); return 0.5f * x * (1.f + t); }
__device__ __forceinline__ void store8(bf16_t* p, f32x4 a, f32x4 b) { u32x4 w; w.x = cvt_pk_bf16(a[0], a[1]); w.y = cvt_pk_bf16(a[2], a[3]); w.z = cvt_pk_bf16(b[0], b[1]); w.w = cvt_pk_bf16(b[2], b[3]); *(u32x4*)p = w; }
typedef __bf16 bf16x2_t __attribute__((ext_vector_type(2)));
__device__ __forceinline__ unsigned cvt_pk_safe(float lo, float hi) { const f32x2 v = {lo, hi}; const bf16x2_t b = __builtin_convertvector(v, bf16x2_t); return __builtin_bit_cast(unsigned, b); }
__device__ __forceinline__ unsigned pk2(float lo, float hi) { return cvt_pk_safe(lo, hi); }
__device__ __forceinline__ unsigned f2bf(float f) { return cvt_pk_safe(f, 0.f) & 0xffffu; }
__device__ __forceinline__ float sum4(f32x4 a) { return (a[0] + a[1]) + (a[2] + a[3]); }
__device__ __forceinline__ float sq4(f32x4 a) { return (a[0] * a[0] + a[1] * a[1]) + (a[2] * a[2] + a[3] * a[3]); }
__device__ __forceinline__ void load_rstd8(const float* ssx, int rbase, float (&rs)[2][4]) {
    f32x4 t[2][4];
#pragma unroll
    for (int ai = 0; ai < 2; ++ai)
#pragma unroll
        for (int m = 0; m < 4; ++m) t[ai][m] = *(const f32x4*)(ssx + (size_t)(rbase + ai * 128 + m * 16) * 4);
#pragma unroll
    for (int ai = 0; ai < 2; ++ai)
#pragma unroll
        for (int m = 0; m < 4; ++m) rs[ai][m] = __builtin_amdgcn_rsqf(sum4(t[ai][m]) * (1.f / 1024.f) + EPS);
}

#define XB_TMO      128
#define XB_XCNT(j)  (256  + 64 * (j))
#define XB_XSUB(j)  (1280 + 64 * (j))
#define XB_XGEN(j)  (2304 + 64 * (j))
#define XB_TOP      3328
#define XB_TOPGEN   3392
#define XCD_BAR_WORDS 3456
#define XB_SPIN_CAP (1u << 18)

__device__ __forceinline__ unsigned xb_ld(unsigned* p)              { return __hip_atomic_load(p, __ATOMIC_RELAXED, __HIP_MEMORY_SCOPE_AGENT); }
__device__ __forceinline__ unsigned xb_add(unsigned* p, unsigned v) { return __hip_atomic_fetch_add(p, v, __ATOMIC_RELAXED, __HIP_MEMORY_SCOPE_AGENT); }
__device__ __forceinline__ unsigned xb_xcc_id() { return (unsigned)__builtin_amdgcn_s_getreg((3 << 11) | 20) & 0xFu; }
#define XB_SPIN(cond, bar) do { unsigned _sp = 0; while (cond) { __builtin_amdgcn_s_sleep(1); \
    if ((++_sp & 255u) == 0u) { if (xb_ld(&(bar)[XB_TMO])) break; if (_sp > XB_SPIN_CAP) { atomicAdd(&(bar)[XB_TMO], 1u); break; } } } } while (0)

struct XcdBarrier {
    unsigned* bar; unsigned x;
    volatile LAS unsigned* st;
};

__device__ __forceinline__ XcdBarrier xcd_barrier_post(unsigned* bar, volatile LAS unsigned* st) {
    XcdBarrier b; b.bar = bar; b.x = xb_xcc_id(); b.st = st;
    if (threadIdx.x == 0) (void)xb_add(&bar[XB_XCNT(b.x)], 1u);
    return b;
}
__device__ __forceinline__ void xcd_barrier_complete(unsigned* bar, unsigned x, unsigned& nloc, unsigned& nx) {
    const unsigned G = gridDim.x * gridDim.y * gridDim.z;
    unsigned sum, cnt, mine, sp = 0u;
    for (;;) {
        sum = 0u; cnt = 0u; mine = 0u;
#pragma unroll
        for (unsigned j = 0; j < 16; ++j) { const unsigned c = xb_ld(&bar[XB_XCNT(j)]); sum += c; cnt += (c > 0u) ? 1u : 0u; mine = (j == x) ? c : mine; }
        if (sum == G) break;
        __builtin_amdgcn_s_sleep(1);
        if ((++sp & 255u) == 0u) { if (xb_ld(&bar[XB_TMO])) break; if (sp > XB_SPIN_CAP) { atomicAdd(&bar[XB_TMO], 1u); break; } }
    }
    nloc = mine > 0u ? mine : 1u; nx = cnt > 0u ? cnt : 1u;
}

__device__ __forceinline__ void xcd_barrier(const XcdBarrier& b) {
    asm volatile("s_waitcnt vmcnt(0)" ::: "memory");
    __syncthreads();
    if (threadIdx.x == 0) {
        unsigned* bar = b.bar;
        __builtin_amdgcn_s_waitcnt(0);
        unsigned nloc = b.st[0], nx = b.st[1];
        if (nloc == 0u) { xcd_barrier_complete(bar, b.x, nloc, nx); b.st[0] = nloc; b.st[1] = nx; }
        const unsigned old = xb_add(&bar[XB_XSUB(b.x)], 1u);
        const unsigned gen = old / nloc;
        if (old + 1u == (gen + 1u) * nloc) {
            __builtin_amdgcn_fence(__ATOMIC_RELEASE, "agent");
            asm volatile("s_waitcnt vmcnt(0)" ::: "memory");
            const unsigned og = xb_add(&bar[XB_TOP], 1u);
            const unsigned tg = og / nx;
            if (og + 1u == (tg + 1u) * nx) xb_add(&bar[XB_TOPGEN], 1u);
            else XB_SPIN(xb_ld(&bar[XB_TOPGEN]) == tg, bar);
            __builtin_amdgcn_fence(__ATOMIC_ACQUIRE, "agent");
            xb_add(&bar[XB_XGEN(b.x)], 1u);
            asm volatile("s_waitcnt vmcnt(0)" ::: "memory");
        } else {
            XB_SPIN(xb_ld(&bar[XB_XGEN(b.x)]) == gen, bar);
            __builtin_amdgcn_fence(__ATOMIC_ACQUIRE, "agent");
            asm volatile("s_waitcnt vmcnt(0)" ::: "memory");
        }
    }
    __syncthreads();
}

__device__ __forceinline__ size_t ka_off(int bh, int s, int d);
__device__ __forceinline__ size_t km_off(int bh, int s, int d);
__device__ __forceinline__ size_t vf_off(int bh, int key, int dv);
struct EpiIn {
    static constexpr bool PERM = true, AFTER_DRAIN = false;
    unsigned char* ws;
    __device__ __forceinline__ void operator()(const f32x4 (&acc)[2][2][4][2], const Unit& u, int wr, int wc, int fr_, int fq_) const {
        int fr = fr_, fq = fq_; asm volatile("" : "+v"(fr), "+v"(fq));
        const int pn = u.pn;
        const float* ssx = (const float*)(ws + WS_SSX); float* ssq = (float*)(ws + WS_SSQ); float* ssk = (float*)(ws + WS_SSK); float* kpga = (float*)(ws + WS_KPGA);
        bf16_t* Qa = (bf16_t*)(ws + WS_QA); bf16_t* Ka = (bf16_t*)(ws + WS_KA); bf16_t* Vta = (bf16_t*)(ws + WS_VTA); bf16_t* Qm = (bf16_t*)(ws + WS_QM); bf16_t* Km = (bf16_t*)(ws + WS_KM); bf16_t* Vtm = (bf16_t*)(ws + WS_VTM);
        bf16_t* proj = (bf16_t*)(ws + WS_PROJ); const float* ropeM = (const float*)(ws + WS_ROPEM);
        float rs8[2][4]; load_rstd8(ssx, u.pm * 256 + wr * 64 + fr, rs8);
#pragma unroll
        for (int ai = 0; ai < 2; ++ai)
#pragma unroll
            for (int m = 0; m < 4; ++m) {
                int r = u.pm * 256 + ai * 128 + wr * 64 + m * 16 + fr; asm volatile("" : "+v"(r));
                const float rs = rs8[ai][m];
                f32x4 v[2][2];
#pragma unroll
                for (int bj = 0; bj < 2; ++bj)
#pragma unroll
                    for (int n = 0; n < 2; ++n) v[bj][n] = acc[ai][bj][m][n] * rs;
                const int b = r >> 12, s = r & 4095;
                if (pn == 0) {
                    float q = (sq4(v[0][0]) + sq4(v[0][1])) + (sq4(v[1][0]) + sq4(v[1][1]));
                    q += __shfl_xor(q, 16); q += __shfl_xor(q, 32);
                    if (fq == 0) ssq[(size_t)r * 4 + wc] = q;
                } else if (pn == 1) {
                    float q = sq4(v[0][0]) + sq4(v[0][1]);
                    q += __shfl_xor(q, 16); q += __shfl_xor(q, 32);
                    if (fq == 0) ssk[(size_t)r * 4 + wc] = q;
                    if (wc == 0) { float* o = kpga + (size_t)r * 48 + 8 * fq; *(f32x4*)o = v[1][0]; *(f32x4*)(o + 4) = v[1][1]; }
                    else if (wc == 1 && fq < 2) { float* o = kpga + (size_t)r * 48 + 32 + 8 * fq; *(f32x4*)o = v[1][0]; *(f32x4*)(o + 4) = v[1][1]; }
                } else if (pn == 2) {
#pragma unroll
                    for (int bj = 0; bj < 2; ++bj) { const int h = 2 * bj + (wc >> 1), d0 = (wc & 1) * 32 + 8 * fq;
                        store8(Qa + ((size_t)(b * 4 + h) * S + s) * 96 + d0, v[bj][0], v[bj][1]); }
                } else if (pn == 4) {
#pragma unroll
                    for (int bj = 0; bj < 2; ++bj) { const int h = 2 * bj + (wc >> 1), d0 = (wc & 1) * 32 + 8 * fq;
                        store8(Ka + ka_off(b * 4 + h, s, d0), v[bj][0], v[bj][1]); }
                } else if (pn == 3) {
                    store8(Qa + ((size_t)(b * 4 + wc) * S + s) * 96 + 64 + 8 * fq, v[0][0], v[0][1]);
                    store8(proj + (size_t)r * NPJ + 32 * wc + 8 * fq, v[1][0], v[1][1]);
                } else if (pn == 5 || pn == 11) {
                    bf16_t* base = (pn == 5) ? Vta : Vtm;
#pragma unroll
                    for (int bj = 0; bj < 2; ++bj)
#pragma unroll
                        for (int n = 0; n < 2; ++n)
#pragma unroll
                            for (int i = 0; i < 4; ++i) { const int cl = 128 * bj + 32 * wc + 8 * fq + 4 * n + i; base[vf_off(b * 4 + (cl >> 6), s, cl & 63)] = (bf16_t)f2bf(v[bj][n][i]); }
                } else if (pn == 6) {
                    store8(proj + (size_t)r * NPJ + 128 + 32 * wc + 8 * fq, v[0][0], v[0][1]);
                } else if (pn == 9 || pn == 10) {
                    const float sc = (pn == 9) ? C_MOBA : 1.f;
                    const bool rot = ((wc & 1) == 0) && (fq < 2);
                    f32x4 cs = (f32x4){1.f, 1.f, 1.f, 1.f}, sn = (f32x4){0.f, 0.f, 0.f, 0.f};
                    if (rot) { cs = *(const f32x4*)(ropeM + (size_t)s * 8 + 4 * fq); sn = *(const f32x4*)(ropeM + (size_t)S * 8 + (size_t)s * 8 + 4 * fq); }
#pragma unroll
                    for (int bj = 0; bj < 2; ++bj) { const int h = 2 * bj + (wc >> 1), p0 = (wc & 1) * 32 + 8 * fq;
                        f32x4 x1 = v[bj][0], x2 = v[bj][1];
                        if (rot) { const f32x4 o1 = x1 * cs - x2 * sn, o2 = x2 * cs + x1 * sn; x1 = o1; x2 = o2; }
                        bf16_t* dst = (pn == 9) ? Qm + ((size_t)(b * 4 + h) * S + s) * 64 + p0 : Km + km_off(b * 4 + h, s, p0);
                        store8(dst, x1 * sc, x2 * sc); }
                } else {
                    const int off = (pn == 7) ? 256 : (pn == 8) ? 512 : (pn == 12) ? 768 : 1024;
#pragma unroll
                    for (int bj = 0; bj < 2; ++bj) store8(proj + (size_t)r * NPJ + off + 128 * bj + 32 * wc + 8 * fq, v[bj][0], v[bj][1]);
                }
                asm volatile("" ::: "memory"); __builtin_amdgcn_sched_barrier(0);
            }
    }
};
struct EpiRes {
    static constexpr bool PERM = true, AFTER_DRAIN = true;
    const float* xold; float* xnew; unsigned char* ws;
    __device__ __forceinline__ void operator()(const f32x4 (&)[2][2][4][2], const Unit&, int, int, int, int) const {}
    __device__ __forceinline__ void fused(f32x4 (&acc)[2][2][4][2], const Unit& u, int wr, int wc, int fr, int fq, PG8_LAS unsigned char* lds, int wid, int lane) const {
        bf16_t* xbf = (bf16_t*)(ws + WS_XBF); float* ssx = (float*)(ws + WS_SSX);
        PG8_LAS float* P = (PG8_LAS float*)lds;
#pragma unroll
        for (int ai = 0; ai < 2; ++ai)
#pragma unroll
            for (int m = 0; m < 4; ++m) {
                const int rl = ai * 128 + wr * 64 + m * 16 + fr, r = u.pm * 256 + rl; float q = 0.f;
#pragma unroll
                for (int bj = 0; bj < 2; ++bj) { const size_t off = (size_t)r * DM + u.pn * 256 + 128 * bj + 32 * wc + 8 * fq;
                    const f32x4 o0 = *(const f32x4*)(xold + off) + acc[ai][bj][m][0], o1 = *(const f32x4*)(xold + off + 4) + acc[ai][bj][m][1];
                    *(f32x4*)(xnew + off) = o0; *(f32x4*)(xnew + off + 4) = o1; store8(xbf + off, o0, o1); q += sq4(o0) + sq4(o1); }
                q += __shfl_xor(q, 16); q += __shfl_xor(q, 32);
                if (fq == 0) P[rl * 4 + wc] = q;
                if (m & 1) { asm volatile("" ::: "memory"); __builtin_amdgcn_sched_barrier(0); }
            }
        asm volatile("s_waitcnt lgkmcnt(0)" ::: "memory"); __builtin_amdgcn_s_barrier(); asm volatile("" ::: "memory");
        const int t = wid * 64 + lane;
        if (t < 256) { const f32x4 pv = *(const PG8_LAS f32x4*)(P + t * 4); ssx[(size_t)(u.pm * 256 + t) * 4 + u.pn] = sum4(pv); }
        asm volatile("s_waitcnt lgkmcnt(0)" ::: "memory"); __builtin_amdgcn_s_barrier(); asm volatile("" ::: "memory");
    }
};
struct EpiResFinal {
    static constexpr bool PERM = true, AFTER_DRAIN = true;
    const float* xold; float* out; const float* gain; float* slots  ; unsigned* cnt  ;
    __device__ __forceinline__ void operator()(const f32x4 (&)[2][2][4][2], const Unit&, int, int, int, int) const {}
    __device__ __forceinline__ void fused(f32x4 (&acc)[2][2][4][2], const Unit& u, int wr, int wc, int fr, int fq, PG8_LAS unsigned char* lds, int wid, int lane) const {
        PG8_LAS float* P = (PG8_LAS float*)lds;
        PG8_LAS float* Sr = (PG8_LAS float*)(lds + 4096);
#pragma unroll
        for (int ai = 0; ai < 2; ++ai)
#pragma unroll
            for (int m = 0; m < 4; ++m) {
                const int rl = ai * 128 + wr * 64 + m * 16 + fr, r = u.pm * 256 + rl; float q = 0.f;
#pragma unroll
                for (int bj = 0; bj < 2; ++bj) { const size_t off = (size_t)r * DM + u.pn * 256 + 128 * bj + 32 * wc + 8 * fq;
                    acc[ai][bj][m][0] += *(const f32x4*)(xold + off); acc[ai][bj][m][1] += *(const f32x4*)(xold + off + 4); q += sq4(acc[ai][bj][m][0]) + sq4(acc[ai][bj][m][1]); }
                q += __shfl_xor(q, 16); q += __shfl_xor(q, 32);
                if (fq == 0) P[rl * 4 + wc] = q;
                if (m & 1) { asm volatile("" ::: "memory"); __builtin_amdgcn_sched_barrier(0); }
            }
        asm volatile("s_waitcnt lgkmcnt(0)" ::: "memory"); __builtin_amdgcn_s_barrier(); asm volatile("" ::: "memory");
        const int t = wid * 64 + lane;
        if (t < 256) { const f32x4 pv = *(const PG8_LAS f32x4*)(P + t * 4); __hip_atomic_store(slots + (size_t)(u.pm * 256 + t) * 4 + u.pn, sum4(pv), __ATOMIC_RELAXED, __HIP_MEMORY_SCOPE_AGENT); }
        asm volatile("s_waitcnt vmcnt(0)" ::: "memory");
        __builtin_amdgcn_s_barrier(); asm volatile("" ::: "memory");
        if (t == 0) {
            __hip_atomic_fetch_add(cnt + 64 * u.pm, 1u, __ATOMIC_RELAXED, __HIP_MEMORY_SCOPE_AGENT);
            unsigned sp = 0u;
            while (__hip_atomic_load(cnt + 64 * u.pm, __ATOMIC_RELAXED, __HIP_MEMORY_SCOPE_AGENT) < 4u) { __builtin_amdgcn_s_sleep(2); if (++sp > (1u << 22)) break; }
            __builtin_amdgcn_fence(__ATOMIC_ACQUIRE, "agent");
        }
        asm volatile("s_waitcnt vmcnt(0) lgkmcnt(0)" ::: "memory"); __builtin_amdgcn_s_barrier(); asm volatile("" ::: "memory");
        if (t < 256) { const float* sl = slots + (size_t)(u.pm * 256 + t) * 4; float s = 0.f;
#pragma unroll
            for (int k = 0; k < 4; ++k) s += __hip_atomic_load(sl + k, __ATOMIC_RELAXED, __HIP_MEMORY_SCOPE_AGENT);
            Sr[t] = __builtin_amdgcn_rsqf(s * (1.f / 1024.f) + EPS); }
        asm volatile("s_waitcnt vmcnt(0) lgkmcnt(0)" ::: "memory"); __builtin_amdgcn_s_barrier(); asm volatile("" ::: "memory");
#pragma unroll
        for (int ai = 0; ai < 2; ++ai)
#pragma unroll
            for (int m = 0; m < 4; ++m) {
                const int rl = ai * 128 + wr * 64 + m * 16 + fr, r = u.pm * 256 + rl; const float rs = Sr[rl];
#pragma unroll
                for (int bj = 0; bj < 2; ++bj) { const int col = u.pn * 256 + 128 * bj + 32 * wc + 8 * fq; const size_t off = (size_t)r * DM + col;
                    *(f32x4*)(out + off) = acc[ai][bj][m][0] * rs * *(const f32x4*)(gain + col); *(f32x4*)(out + off + 4) = acc[ai][bj][m][1] * rs * *(const f32x4*)(gain + col + 4); }
            }
    }
};
struct EpiSwi {
    static constexpr bool PERM = true, AFTER_DRAIN = false;
    unsigned char* ws;
    __device__ __forceinline__ void operator()(const f32x4 (&acc)[2][2][4][2], const Unit& u, int wr, int wc, int fr_, int fq_) const {
        int fr = fr_, fq = fq_; asm volatile("" : "+v"(fr), "+v"(fq));
        const float* ssx = (const float*)(ws + WS_SSX); bf16_t* act = (bf16_t*)(ws + WS_ACT);
        float rs8[2][4]; load_rstd8(ssx, u.pm * 256 + wr * 64 + fr, rs8);
#pragma unroll
        for (int ai = 0; ai < 2; ++ai)
#pragma unroll
            for (int m = 0; m < 4; ++m) {
                const int r = u.pm * 256 + ai * 128 + wr * 64 + m * 16 + fr;
                const float rs = rs8[ai][m];
                f32x4 o[2];
#pragma unroll
                for (int n = 0; n < 2; ++n) { const f32x4 g = acc[ai][0][m][n] * rs, up = acc[ai][1][m][n] * rs;
#pragma unroll
                    for (int i = 0; i < 4; ++i) o[n][i] = g[i] * __builtin_amdgcn_rcpf(1.f + __expf(-g[i])) * up[i]; }
                store8(act + (size_t)r * FF + u.pn * 128 + 32 * wc + 8 * fq, o[0], o[1]);
                __builtin_amdgcn_sched_barrier(0);
            }
    }
};

__device__ __forceinline__ int sigperm(int p) { return p < 16 ? (((p >> 2) & 1) * 8 + ((p >> 3) & 1) * 4 + (p & 3)) : p; }
struct MapIn { const float* win; const float* wfq; const float* wfkv;
    __device__ __forceinline__ void operator()(int n, const float*& src, int& ld, int& col) const {
        const int t = n >> 8, c = n & 255; src = win; ld = INW; col = 0;
        switch (t) {
            case 0: col = c; break;
            case 1: if (c < 128) col = 256 + c; else if (c < 160) col = 384 + (c - 128); else if (c < 176) col = 928 + (c - 160); else src = nullptr; break;
            case 2: src = wfq; ld = 384; col = (c >> 6) * 96 + (c & 63); break;
            case 3: if (c < 128) { src = wfq; ld = 384; col = (c >> 5) * 96 + 64 + (c & 31); } else col = 416 + (c - 128); break;
            case 4: src = wfkv; ld = 512; col = (c >> 6) * 128 + (c & 63); break;
            case 5: src = wfkv; ld = 512; col = (c >> 6) * 128 + 64 + (c & 63); break;
            case 6: if (c < 128) col = 544 + c; else src = nullptr; break;
            case 7: col = 672 + c; break;
            case 8: col = 944 + c; break;
            case 9: col = 1200 + (c & ~63) + sigperm(c & 63); break;
            case 10: col = 1456 + (c & ~63) + sigperm(c & 63); break;
            case 11: col = 1712 + c; break;
            case 12: col = 1968 + c; break;
            default: col = 2224 + c; break;
        }
    }
};
struct MapPlain { const float* w; int N;
    __device__ __forceinline__ void operator()(int n, const float*& src, int& ld, int& col) const { src = w; ld = N; col = n; } };
struct MapFfnIn { const float* w;
    __device__ __forceinline__ void operator()(int n, const float*& src, int& ld, int& col) const { const int t = n >> 8, c = n & 255; src = w; ld = NFI; col = (c < 128) ? (128 * t + c) : (FF + 128 * t + (c - 128)); } };
template <class Map> __device__ __forceinline__ void transpose_item(const Map& mp, int K, int nblk, bf16_t* WT, const float* gain, LAS float* scr, int item, int lane) {
    const int kb = item / nblk, nb = item % nblk, k0 = 64 * kb, n0 = 32 * nb;
    const float* src; int ld, col; mp(n0 + (lane & 31), src, ld, col);
    float vv[32];
#pragma unroll
    for (int i = 0; i < 32; ++i) { const int kk = 2 * i + (lane >> 5); vv[i] = src ? src[(size_t)(k0 + kk) * ld + col] : 0.f; }
#pragma unroll
    for (int i = 0; i < 32; ++i) { const int kk = 2 * i + (lane >> 5); float v = vv[i]; if (gain) v *= gain[k0 + kk]; scr[kk * 33 + (lane & 31)] = v; }
    asm volatile("s_waitcnt lgkmcnt(0)" ::: "memory");
    const int c = lane & 7;
#pragma unroll
    for (int j = 0; j < 4; ++j) { const int n = (lane >> 3) + 8 * j; const LAS float* s = scr + (8 * c) * 33 + n;
        u32x4 o; o.x = pk2(s[0 * 33], s[1 * 33]); o.y = pk2(s[2 * 33], s[3 * 33]); o.z = pk2(s[4 * 33], s[5 * 33]); o.w = pk2(s[6 * 33], s[7 * 33]);
        *(u32x4*)(WT + (size_t)(n0 + n) * K + k0 + 8 * c) = o; }
    asm volatile("s_waitcnt lgkmcnt(0)" ::: "memory");
}
__device__ __forceinline__ void convert_ffn_weights(const Params& p, int l, LAS unsigned char* lds, int gwave, int gwaves, int wave, int lane) {
    LAS float* scr = (LAS float*)(lds + wave * 16384);
    unsigned char* ws = WSP();
    constexpr int I_FI = (DM / 64) * (NFI / 32), I_FO = (FF / 64) * (DM / 32);
    const MapFfnIn mfi{INP(I_W_FFN_IN) + (size_t)l * DM * NFI}; const MapPlain mfo{INP(I_W_FFN_OUT) + (size_t)l * FF * DM, DM};
    for (int it = gwave; it < I_FI + I_FO; it += gwaves) {
        if (it < I_FI) transpose_item(mfi, DM, NFI / 32, (bf16_t*)(ws + WS_WFI), INP(I_FFN_NORM) + l * DM, scr, it, lane);
        else transpose_item(mfo, FF, DM / 32, (bf16_t*)(ws + WS_WFO), nullptr, scr, it - I_FI, lane);
    }
}
__device__ __forceinline__ void fuse_weights(LAS unsigned char* lds, int tid) {
    unsigned char* ws = WSP(); LAS float* As = (LAS float*)lds; LAS float* Bs = As + 64 * 33;
    for (int it = blockIdx.x; it < 448; it += gridDim.x) {
        const int l = it / 224, r_ = it - l * 224; const bool isq = r_ < 96; const int tt = isq ? r_ : r_ - 96, nj = isq ? 6 : 8, kt = tt / nj, jt = tt - kt * nj;
        const int R = isq ? 256 : 128, NU = isq ? 384 : 512, roff = isq ? 0 : 256;
        const float* win = INP(I_W_IN) + (size_t)l * DM * INW + (size_t)(kt * 64) * INW + roff;
        const float* g = isq ? INP(I_Q_NORM) + l * 256 : INP(I_KV_NORM) + l * 128;
        const float* wu = (isq ? INP(I_W_UQ) + (size_t)l * 256 * 384 : INP(I_W_UKV) + (size_t)l * 128 * 512) + jt * 64;
        float* o = (isq ? (float*)(ws + WS_WFQ) + (size_t)l * DM * 384 : (float*)(ws + WS_WFKV) + (size_t)l * DM * 512) + (size_t)(kt * 64) * NU + jt * 64;
        const int ty = tid >> 4, tx = tid & 15; float acc[2][4];
#pragma unroll
        for (int x = 0; x < 2; ++x)
#pragma unroll
            for (int y = 0; y < 4; ++y) acc[x][y] = 0.f;
        for (int r0 = 0; r0 < R; r0 += 32) {
            __syncthreads();
#pragma unroll
            for (int i = 0; i < 4; ++i) { const int e = tid + 512 * i, kk = e >> 5, rr = e & 31; As[kk * 33 + rr] = win[(size_t)kk * INW + r0 + rr] * g[r0 + rr]; }
#pragma unroll
            for (int i = 0; i < 4; ++i) { const int e = tid + 512 * i, rr = e >> 6, jj = e & 63; Bs[rr * 64 + jj] = wu[(size_t)(r0 + rr) * NU + jj]; }
            __syncthreads();
#pragma unroll 8
            for (int rr = 0; rr < 32; ++rr) { const float a0 = As[(2 * ty) * 33 + rr], a1 = As[(2 * ty + 1) * 33 + rr]; const f32x4 bv = *(const LAS f32x4*)(Bs + rr * 64 + 4 * tx);
#pragma unroll
                for (int y = 0; y < 4; ++y) { acc[0][y] += a0 * bv[y]; acc[1][y] += a1 * bv[y]; } }
        }
#pragma unroll
        for (int x = 0; x < 2; ++x) *(f32x4*)(o + (size_t)(2 * ty + x) * NU + 4 * tx) = (f32x4){acc[x][0], acc[x][1], acc[x][2], acc[x][3]};
    }
    __syncthreads();
}
__device__ __forceinline__ void prologue_a(const Params& p, int gtid, int gthreads, int gwave, int gwaves, int lane) {
    unsigned char* ws = WSP();
    { const float* x = INP(I_X); bf16_t* xbf = (bf16_t*)(ws + WS_XBF); float* ssx = (float*)(ws + WS_SSX);
      for (int r2 = gwave; r2 < T / 2; r2 += gwaves) { f32x4 v[2][4];
#pragma unroll
          for (int u = 0; u < 2; ++u) { const f32x4* xr = (const f32x4*)(x + (size_t)(2 * r2 + u) * DM) + lane;
#pragma unroll
              for (int j = 0; j < 4; ++j) v[u][j] = xr[64 * j]; }
#pragma unroll
          for (int u = 0; u < 2; ++u) { const int r = 2 * r2 + u; float s = 0.f;
#pragma unroll
              for (int j = 0; j < 4; ++j) s += sq4(v[u][j]);
              s = wave_sum(s);
              unsigned long long* o8 = (unsigned long long*)(xbf + (size_t)r * DM) + lane;
#pragma unroll
              for (int j = 0; j < 4; ++j) o8[64 * j] = (unsigned long long)pk2(v[u][j][0], v[u][j][1]) | ((unsigned long long)pk2(v[u][j][2], v[u][j][3]) << 32);
              if (lane < 4) ssx[(size_t)r * 4 + lane] = (lane == 0) ? s : 0.f; } } }
    { float* ra = (float*)(ws + WS_ROPEA); float* rm = (float*)(ws + WS_ROPEM);
      for (int idx = gtid; idx < S * 24; idx += gthreads) { const int s = idx / 24, j = idx - s * 24; const double f = (j < 16) ? exp(-13.122363377404328 * (double)(2 * j) / 32.0) : exp(-13.122363377404328 * (double)(2 * (j - 16)) / 16.0);
          double rv = (double)s * f * 0.15915494309189535; rv -= floor(rv); const float fr = (float)rv;
          const float c = __builtin_amdgcn_cosf(fr), sn = __builtin_amdgcn_sinf(fr);
          if (j < 16) { ra[s * 16 + j] = c; ra[S * 16 + s * 16 + j] = sn; } else { rm[s * 8 + (j - 16)] = c; rm[S * 8 + s * 8 + (j - 16)] = sn; } } }
}
__device__ __forceinline__ void prologue_b(const Params& p, LAS unsigned char* lds, int gwave, int gwaves, int wave, int lane) {
    LAS float* scr = (LAS float*)(lds + wave * 16384);
    unsigned char* ws = WSP();
    constexpr int I_IN = (DM / 64) * (NIN / 32), I_OUT = (DM / 64) * (DM / 32);
    for (int it = gwave; it < 2 * (I_IN + I_OUT); it += gwaves) {
        const int l = it / (I_IN + I_OUT), r = it - l * (I_IN + I_OUT);
        if (r < I_IN) { const MapIn mi{INP(I_W_IN) + (size_t)l * DM * INW, (const float*)(ws + WS_WFQ) + (size_t)l * DM * 384, (const float*)(ws + WS_WFKV) + (size_t)l * DM * 512};
            transpose_item(mi, DM, NIN / 32, (bf16_t*)(ws + WS_WIN) + (size_t)l * NIN * DM, INP(I_ATTN_NORM) + l * DM, scr, r, lane); }
        else { const MapPlain mo{INP(I_W_OUT) + (size_t)l * DM * DM, DM};
            transpose_item(mo, DM, DM / 32, (bf16_t*)(ws + WS_WOUT) + (size_t)l * DM * DM, nullptr, scr, r - I_IN, lane); }
    }
    convert_ffn_weights(p, 0, lds, gwave, gwaves, wave, lane);
}

typedef float f32x16 __attribute__((ext_vector_type(16)));
using pg8::bf16x8;
#define ZERO16(v) do { _Pragma("unroll") for (int i_ = 0; i_ < 16; ++i_) v[i_] = 0.f; } while (0)

__device__ __forceinline__ void mid_mla(const Params& p, int gtid, int gthreads) {
    unsigned char* ws = WSP();
    bf16_t* Qa = (bf16_t*)(ws + WS_QA); bf16_t* Ka = (bf16_t*)(ws + WS_KA); bf16_t* Vta = (bf16_t*)(ws + WS_VTA);
    const float* ssq = (const float*)(ws + WS_SSQ); const float* ssk = (const float*)(ws + WS_SSK); const float* kpga = (const float*)(ws + WS_KPGA);
    const float* rc = (const float*)(ws + WS_ROPEA); const float* rsn = rc + S * 16;
    for (int idx = gtid; idx < T * 4; idx += gthreads) {
        const int b = idx / (4 * S), s = idx & (S - 1), r = b * S + s;
        const float rq = __builtin_amdgcn_rsqf(sum4(*(const f32x4*)(ssq + (size_t)r * 4)) * (1.f / 256.f) + EPS) * C_MLA;
        const float rk = __builtin_amdgcn_rsqf(sum4(*(const f32x4*)(ssk + (size_t)r * 4)) * (1.f / 128.f) + EPS);
        u32x4* q = (u32x4*)(Qa + (size_t)idx * 96); u32x4* k = (u32x4*)(Ka + ka_off(idx >> 12, s, 0));
        u32x4 qv[8], kv[8];
#pragma unroll
        for (int c = 0; c < 8; ++c) { qv[c] = q[c]; kv[c] = k[32 * c]; }
#pragma unroll
        for (int c = 0; c < 8; ++c) { u32x4 w = qv[c];
            w.x = pk2(bflo(w.x) * rq, bfhi(w.x) * rq); w.y = pk2(bflo(w.y) * rq, bfhi(w.y) * rq); w.z = pk2(bflo(w.z) * rq, bfhi(w.z) * rq); w.w = pk2(bflo(w.w) * rq, bfhi(w.w) * rq); q[c] = w;
            u32x4 z = kv[c];
            z.x = pk2(bflo(z.x) * rk, bfhi(z.x) * rk); z.y = pk2(bflo(z.y) * rk, bfhi(z.y) * rk); z.z = pk2(bflo(z.z) * rk, bfhi(z.z) * rk); z.w = pk2(bflo(z.w) * rk, bfhi(z.w) * rk); k[32 * c] = z; }
#pragma unroll
        for (int c = 0; c < 2; ++c) {
            const u32x4 a = q[8 + c], bq = q[10 + c];
            const f32x4 c0 = *(const f32x4*)(rc + s * 16 + 8 * c), c1 = *(const f32x4*)(rc + s * 16 + 8 * c + 4), s0 = *(const f32x4*)(rsn + s * 16 + 8 * c), s1 = *(const f32x4*)(rsn + s * 16 + 8 * c + 4);
            const float x1[8] = {bflo(a.x), bfhi(a.x), bflo(a.y), bfhi(a.y), bflo(a.z), bfhi(a.z), bflo(a.w), bfhi(a.w)};
            const float x2[8] = {bflo(bq.x), bfhi(bq.x), bflo(bq.y), bfhi(bq.y), bflo(bq.z), bfhi(bq.z), bflo(bq.w), bfhi(bq.w)};
            const float cc[8] = {c0[0], c0[1], c0[2], c0[3], c1[0], c1[1], c1[2], c1[3]}; const float ss[8] = {s0[0], s0[1], s0[2], s0[3], s1[0], s1[1], s1[2], s1[3]};
            float o1[8], o2[8];
#pragma unroll
            for (int i = 0; i < 8; ++i) { o1[i] = (x1[i] * cc[i] - x2[i] * ss[i]) * rq; o2[i] = (x2[i] * cc[i] + x1[i] * ss[i]) * rq; }
            u32x4 w1, w2; w1.x = pk2(o1[0], o1[1]); w1.y = pk2(o1[2], o1[3]); w1.z = pk2(o1[4], o1[5]); w1.w = pk2(o1[6], o1[7]);
            w2.x = pk2(o2[0], o2[1]); w2.y = pk2(o2[2], o2[3]); w2.z = pk2(o2[4], o2[5]); w2.w = pk2(o2[6], o2[7]);
            q[8 + c] = w1; q[10 + c] = w2;
            const f32x4 ka = *(const f32x4*)(kpga + (size_t)r * 48 + 8 * c), kb = *(const f32x4*)(kpga + (size_t)r * 48 + 8 * c + 4), kc = *(const f32x4*)(kpga + (size_t)r * 48 + 16 + 8 * c), kd = *(const f32x4*)(kpga + (size_t)r * 48 + 16 + 8 * c + 4);
            const float y1[8] = {ka[0], ka[1], ka[2], ka[3], kb[0], kb[1], kb[2], kb[3]}; const float y2[8] = {kc[0], kc[1], kc[2], kc[3], kd[0], kd[1], kd[2], kd[3]};
            float e1[8], e2[8];
#pragma unroll
            for (int i = 0; i < 8; ++i) { e1[i] = y1[i] * cc[i] - y2[i] * ss[i]; e2[i] = y2[i] * cc[i] + y1[i] * ss[i]; }
            u32x4 v1, v2; v1.x = pk2(e1[0], e1[1]); v1.y = pk2(e1[2], e1[3]); v1.z = pk2(e1[4], e1[5]); v1.w = pk2(e1[6], e1[7]);
            v2.x = pk2(e2[0], e2[1]); v2.y = pk2(e2[2], e2[3]); v2.z = pk2(e2[4], e2[5]); v2.w = pk2(e2[6], e2[7]);
            k[32 * (8 + c)] = v1; k[32 * (10 + c)] = v2;
        }
    }
    for (int ci = gtid; ci < 16 * S * 8; ci += gthreads) {
        const int bh = ci >> 15, rem = ci & 32767, tile = rem >> 8, i256 = (rem >> 5) & 7, s16 = (i256 >> 1) & 1, hh = i256 & 1;
        const int tok = (bh >> 2) * S + tile * 32 + 16 * s16 + 4 * hh;
        float rk[8];
#pragma unroll
        for (int i = 0; i < 8; ++i) rk[i] = __builtin_amdgcn_rsqf(sum4(*(const f32x4*)(ssk + (size_t)(tok + 8 * (i >> 2) + (i & 3)) * 4)) * (1.f / 128.f) + EPS);
        u32x4* vp = (u32x4*)(Vta + (size_t)ci * 8); u32x4 w = *vp;
        w.x = pk2(bflo(w.x) * rk[0], bfhi(w.x) * rk[1]); w.y = pk2(bflo(w.y) * rk[2], bfhi(w.y) * rk[3]); w.z = pk2(bflo(w.z) * rk[4], bfhi(w.z) * rk[5]); w.w = pk2(bflo(w.w) * rk[6], bfhi(w.w) * rk[7]);
        *vp = w;
    }
}
__device__ __forceinline__ void mid_kmean(const Params& p, LAS unsigned char* lds, int tid) {
    const bf16_t* Km = (const bf16_t*)(WSP() + WS_KM); float* kmean = (float*)(WSP() + WS_KMEAN); LAS float* red = (LAS float*)lds;
    for (int it = blockIdx.x; it < 256; it += gridDim.x) {
        const int d = tid & 63, part = tid >> 6; const bf16_t* base = Km + km_off(it >> 4, (it & 15) * 256 + part * 32, d); float s = 0.f;
        for (int k = 0; k < 32; ++k) s += bf2f(base[k * 8]);
        red[part * 64 + d] = s; __syncthreads();
        if (tid < 64) { float t = 0.f;
#pragma unroll
            for (int q = 0; q < 8; ++q) t += red[q * 64 + tid];
            kmean[it * 64 + tid] = t * (1.f / 256.f); }
        __syncthreads();
    }
}
struct GlaLds { LAS float *alow, *sk, *sv, *sb; };
constexpr int GLA_HS = 16000;
__device__ __forceinline__ void gla_common(const Params& p, int l, int item, const GlaLds& L, int t) {
    const int h = item & 3, bn = item >> 2, r0 = bn * 64;
    const bf16_t* proj = (const bf16_t*)(WSP() + WS_PROJ); const float* kpga = (const float*)(WSP() + WS_KPGA);
    const float* wa2 = INP(I_GLA_WA2) + l * 16 * 128; const float* ba2 = INP(I_GLA_BA2) + l * 128;
    { const int tt = t >> 2, j4 = (t & 3) * 4; *(LAS f32x4*)(L.alow + tt * 16 + j4) = *(const f32x4*)(kpga + (size_t)(r0 + tt) * 48 + 32 + j4); }
    { const int tt = t >> 2, d8 = (t & 3) * 8; const u32x4 w = *(const u32x4*)(proj + (size_t)(r0 + tt) * NPJ + 128 + h * 32 + d8); LAS float* d = L.sk + tt * 33 + d8;
      d[0] = bflo(w.x); d[1] = bfhi(w.x); d[2] = bflo(w.y); d[3] = bfhi(w.y); d[4] = bflo(w.z); d[5] = bfhi(w.z); d[6] = bflo(w.w); d[7] = bfhi(w.w); }
#pragma unroll
    for (int i = 0; i < 2; ++i) { const int c = t + 256 * i, tt = c >> 3, d8 = (c & 7) * 8; const u32x4 w = *(const u32x4*)(proj + (size_t)(r0 + tt) * NPJ + 256 + h * 64 + d8); LAS float* d = L.sv + tt * 64 + d8;
      *(LAS f32x4*)d = (f32x4){bflo(w.x), bfhi(w.x), bflo(w.y), bfhi(w.y)}; *(LAS f32x4*)(d + 4) = (f32x4){bflo(w.z), bfhi(w.z), bflo(w.w), bfhi(w.w)}; }
    __syncthreads();
    for (int i = t; i < 64 * 32; i += 256) { const int tt = i >> 5, d = i & 31; float z = ba2[h * 32 + d];
#pragma unroll
        for (int j = 0; j < 16; ++j) z += L.alow[tt * 16 + j] * wa2[j * 128 + h * 32 + d];
        L.sb[tt * 33 + d] = logsigmoidf_(z) * (1.f / 16.f); }
    __syncthreads();
    { const int d = t & 31, sg = t >> 5;
      float v[8]; float c = 0.f;
#pragma unroll
      for (int k = 0; k < 8; ++k) { c += L.sb[(8 * sg + k) * 33 + d]; v[k] = c; }
      L.alow[sg * 32 + d] = c;
      __syncthreads();
      float off = 0.f;
      for (int s2 = 0; s2 < sg; ++s2) off += L.alow[s2 * 32 + d];
#pragma unroll
      for (int k = 0; k < 8; ++k) L.sb[(8 * sg + k) * 33 + d] = v[k] + off; }
    __syncthreads();
}
__device__ __forceinline__ float* sb_cache() { return (float*)(WSP() + WS_WFQ); }
__device__ __forceinline__ void gla_common_cached(int item, const GlaLds& L, int t) {
    const int h = item & 3, bn = item >> 2, r0 = bn * 64;
    const bf16_t* proj = (const bf16_t*)(WSP() + WS_PROJ); const float* sbc = sb_cache();
    { const int tt = t >> 2, d8 = (t & 3) * 8; const u32x4 w = *(const u32x4*)(proj + (size_t)(r0 + tt) * NPJ + 128 + h * 32 + d8); LAS float* d = L.sk + tt * 33 + d8;
      const f32x4 b0 = *(const f32x4*)(sbc + (size_t)(r0 + tt) * 128 + h * 32 + d8), b1 = *(const f32x4*)(sbc + (size_t)(r0 + tt) * 128 + h * 32 + d8 + 4); LAS float* e = L.sb + tt * 33 + d8;
      d[0] = bflo(w.x); d[1] = bfhi(w.x); d[2] = bflo(w.y); d[3] = bfhi(w.y); d[4] = bflo(w.z); d[5] = bfhi(w.z); d[6] = bflo(w.w); d[7] = bfhi(w.w);
      e[0] = b0[0]; e[1] = b0[1]; e[2] = b0[2]; e[3] = b0[3]; e[4] = b1[0]; e[5] = b1[1]; e[6] = b1[2]; e[7] = b1[3]; }
#pragma unroll
    for (int i = 0; i < 2; ++i) { const int c = t + 256 * i, tt = c >> 3, d8 = (c & 7) * 8; const u32x4 w = *(const u32x4*)(proj + (size_t)(r0 + tt) * NPJ + 256 + h * 64 + d8); LAS float* d = L.sv + tt * 64 + d8;
      *(LAS f32x4*)d = (f32x4){bflo(w.x), bfhi(w.x), bflo(w.y), bfhi(w.y)}; *(LAS f32x4*)(d + 4) = (f32x4){bflo(w.z), bfhi(w.z), bflo(w.w), bfhi(w.w)}; }
    __syncthreads();
}
__device__ __forceinline__ void mid_gla(const Params& p, int l, LAS unsigned char* lds, int tid) {
    const int hb = tid >> 8, t = tid & 255;
    LAS float* f = (LAS float*)lds + hb * GLA_HS; const GlaLds L{f, f + 1024, f + 1024 + 64 * 33, f + 1024 + 64 * 33 + 4096};
    float* gds = (float*)(WSP() + WS_GDS); float* gdec = (float*)(WSP() + WS_GDEC); float* sbc = sb_cache();
    for (int it2 = blockIdx.x; it2 < 512; it2 += gridDim.x) {
        const int item = it2 * 2 + hb;
        gla_common(p, l, item, L, t);
        const int h = item & 3, bn = item >> 2, b = bn >> 6, n = bn & 63, bh = b * 4 + h, r0 = bn * 64;
        { const int tt = t >> 2, d8 = (t & 3) * 8; float bv[8], bl[8];
#pragma unroll
          for (int e = 0; e < 8; ++e) { bv[e] = L.sb[tt * 33 + d8 + e]; bl[e] = L.sb[63 * 33 + d8 + e]; }
          *(f32x4*)(sbc + (size_t)(r0 + tt) * 128 + h * 32 + d8) = (f32x4){bv[0], bv[1], bv[2], bv[3]}; *(f32x4*)(sbc + (size_t)(r0 + tt) * 128 + h * 32 + d8 + 4) = (f32x4){bv[4], bv[5], bv[6], bv[7]};
#pragma unroll
          for (int e = 0; e < 8; ++e) L.sk[tt * 33 + d8 + e] *= __expf(bl[e] - bv[e]); }
        __syncthreads();
        { const int lane = tid & 63, wv = (tid >> 6) & 3, r = lane & 31, hf = lane >> 5;
          if (wv < 2) { const int v0 = 32 * wv; f32x16 D; ZERO16(D);
#pragma unroll
              for (int ks = 0; ks < 4; ++ks) { float fa[8], fb[8];
#pragma unroll
                  for (int e = 0; e < 8; ++e) { const int tt = 16 * ks + 8 * hf + e; fa[e] = L.sk[tt * 33 + r]; fb[e] = L.sv[tt * 64 + v0 + r]; }
                  u32x4 wa, wb; wa.x = cvt_pk_safe(fa[0], fa[1]); wa.y = cvt_pk_safe(fa[2], fa[3]); wa.z = cvt_pk_safe(fa[4], fa[5]); wa.w = cvt_pk_safe(fa[6], fa[7]);
                  wb.x = cvt_pk_safe(fb[0], fb[1]); wb.y = cvt_pk_safe(fb[2], fb[3]); wb.z = cvt_pk_safe(fb[4], fb[5]); wb.w = cvt_pk_safe(fb[6], fb[7]);
                  D = __builtin_amdgcn_mfma_f32_32x32x16_bf16(__builtin_bit_cast(bf16x8, wa), __builtin_bit_cast(bf16x8, wb), D, 0, 0, 0); }
              float* o = gds + (size_t)(bh * 64 + n) * 2048 + v0 + r;
#pragma unroll
              for (int i = 0; i < 16; ++i) o[((i & 3) + 8 * (i >> 2) + 4 * hf) * 64] = D[i]; } }
        if (t < 32) gdec[(bh * 64 + n) * 32 + t] = __expf(L.sb[63 * 33 + t]);
        __syncthreads();
    }
}
__device__ __forceinline__ float neg_expm1(float x) {
    if (x > -0.25f) { float q = 1.f / 720.f; q = q * x + 1.f / 120.f; q = q * x + 1.f / 24.f; q = q * x + 1.f / 6.f; q = q * x + 0.5f; q = q * x + 1.f; return -x * q; }
    return 1.f - __expf(x);
}
__device__ __forceinline__ void mid_lru(const Params& p, int l, LAS unsigned char* lds, int tid) {
    LAS float* sx = (LAS float*)lds; LAS float* sxc = sx + 35 * 256;
    const bf16_t* proj = (const bf16_t*)(WSP() + WS_PROJ);
    float* lra = (float*)(WSP() + WS_LRA); float* lru = (float*)(WSP() + WS_LRU); float* aggA = (float*)(WSP() + WS_AGGA); float* aggU = (float*)(WSP() + WS_AGGU);
    const float* cw = INP(I_CONV_W) + l * 4 * 256; const float* cb = INP(I_CONV_B) + l * 256;
    const float* wa = INP(I_LRU_WA) + l * 4 * 64 * 64; const float* wx = INP(I_LRU_WX) + l * 4 * 64 * 64;
    const float* ba = INP(I_LRU_BA) + l * 256; const float* bx = INP(I_LRU_BX) + l * 256; const float* lam = INP(I_LRU_LAM) + l * 256;
    for (int item = blockIdx.x; item < T / 32; item += gridDim.x) {
        const int r0 = item * 32, s0 = r0 & (S - 1);
        for (int i = tid; i < 35 * 32; i += 512) { const int t = i >> 5, c8 = (i & 31) * 8; const int sp = s0 + t - 3;
            u32x4 w = (u32x4){0u, 0u, 0u, 0u}; if (sp >= 0) w = *(const u32x4*)(proj + (size_t)(r0 + t - 3) * NPJ + 768 + c8);
            LAS float* d = sx + t * 256 + c8; d[0] = bflo(w.x); d[1] = bfhi(w.x); d[2] = bflo(w.y); d[3] = bfhi(w.y); d[4] = bflo(w.z); d[5] = bfhi(w.z); d[6] = bflo(w.w); d[7] = bfhi(w.w); }
        __syncthreads();
        for (int i = tid; i < 32 * 256; i += 512) { const int t = i >> 8, ch = i & 255; float a = cb[ch];
#pragma unroll
            for (int j = 0; j < 4; ++j) a += cw[j * 256 + ch] * sx[(t + j) * 256 + ch];
            sxc[i] = a; }
        __syncthreads();
        const int ch = tid & 255, half = tid >> 8, n = ch >> 6, d = ch & 63;
        f32x2 acc2[16];
#pragma unroll
        for (int t = 0; t < 16; ++t) acc2[t] = (f32x2){0.f, 0.f};
#pragma unroll 2
        for (int c0 = 0; c0 < 64; c0 += 8) { f32x2 w2[8];
#pragma unroll
            for (int cc = 0; cc < 8; ++cc) { w2[cc][0] = wa[(n * 64 + c0 + cc) * 64 + d]; w2[cc][1] = wx[(n * 64 + c0 + cc) * 64 + d]; }
#pragma unroll
            for (int t = 0; t < 16; ++t) { const f32x4 x0 = *(const LAS f32x4*)(sxc + (half * 16 + t) * 256 + n * 64 + c0), x1 = *(const LAS f32x4*)(sxc + (half * 16 + t) * 256 + n * 64 + c0 + 4);
#pragma unroll
                for (int cc = 0; cc < 4; ++cc) { acc2[t] += (f32x2){x0[cc], x0[cc]} * w2[cc]; acc2[t] += (f32x2){x1[cc], x1[cc]} * w2[4 + cc]; } } }
        float ar[16], ai[16];
#pragma unroll
        for (int t = 0; t < 16; ++t) { ar[t] = acc2[t][0]; ai[t] = acc2[t][1]; }
        const float lm = lam[ch], sp = fmaxf(-lm, 0.f) + __logf(1.f + __expf(-fabsf(lm)));
        const float b1 = ba[ch], b2 = bx[ch];
        float A = 1.f, U = 0.f;
#pragma unroll
        for (int t = 0; t < 16; ++t) {
            const float rr = sigmoidf_(ar[t] + b1), ig = sigmoidf_(ai[t] + b2);
            const float la = -8.f * rr * sp, a = __expf(la), mult = __builtin_amdgcn_sqrtf(neg_expm1(2.f * la));
            const float u = mult * ig * sxc[(half * 16 + t) * 256 + ch];
            const size_t o = (size_t)(r0 + half * 16 + t) * 256 + ch; lra[o] = a; lru[o] = u;
            A *= a; U = a * U + u;
        }
        const int b = r0 >> 12, c16 = (s0 >> 4) + half;
        aggA[((size_t)(b * 256 + ch)) * 256 + c16] = A; aggU[((size_t)(b * 256 + ch)) * 256 + c16] = U;
        __syncthreads();
    }
}

__device__ __forceinline__ void seq_scans(const Params& p, LAS unsigned char* lds, int tid, int gwave, int gwaves, int lane) {
    { float* gds = (float*)(WSP() + WS_GDS); const float* gdec = (const float*)(WSP() + WS_GDEC); LAS float* ex = (LAS float*)lds;
      for (int blk = blockIdx.x; blk < 256; blk += gridDim.x) {
          const int el = tid & 127, seg = tid >> 7, idx = blk * 128 + el, bh = idx >> 11, e = idx & 2047, dk = e >> 6;
          float* base = gds + (size_t)bh * 64 * 2048 + (size_t)(seg * 16) * 2048 + e; const float* dc = gdec + (bh * 64 + seg * 16) * 32 + dk;
          float ds[16], dd[16];
#pragma unroll
          for (int j = 0; j < 16; ++j) { ds[j] = base[(size_t)j * 2048]; dd[j] = dc[j * 32]; }
          float A = 1.f, U = 0.f;
#pragma unroll
          for (int j = 0; j < 16; ++j) { U = dd[j] * U + ds[j]; A *= dd[j]; }
          ex[(seg * 128 + el) * 2] = A; ex[(seg * 128 + el) * 2 + 1] = U;
          __syncthreads();
          float st = 0.f;
          for (int s2 = 0; s2 < seg; ++s2) st = ex[(s2 * 128 + el) * 2] * st + ex[(s2 * 128 + el) * 2 + 1];
#pragma unroll
          for (int j = 0; j < 16; ++j) { base[(size_t)j * 2048] = st; st = dd[j] * st + ds[j]; }
          __syncthreads();
      } }
    { const float* aggA = (const float*)(WSP() + WS_AGGA); const float* aggU = (const float*)(WSP() + WS_AGGU); float* carry = (float*)(WSP() + WS_CARRY);
      for (int it = gwave; it < 1024; it += gwaves) {
          const f32x4 a = *(const f32x4*)(aggA + (size_t)it * 256 + 4 * lane), u = *(const f32x4*)(aggU + (size_t)it * 256 + 4 * lane);
          float At = a[0], Ut = u[0];
#pragma unroll
          for (int k = 1; k < 4; ++k) { Ut = a[k] * Ut + u[k]; At = At * a[k]; }
#pragma unroll
          for (int off = 1; off < 64; off <<= 1) { const float Ao = __shfl_up(At, off), Uo = __shfl_up(Ut, off); if (lane >= off) { Ut = At * Uo + Ut; At = Ao * At; } }
          float hin = __shfl_up(Ut, 1); if (lane == 0) hin = 0.f;
          f32x4 c; c[0] = hin; c[1] = a[0] * c[0] + u[0]; c[2] = a[1] * c[1] + u[1]; c[3] = a[2] * c[2] + u[2];
          *(f32x4*)(carry + (size_t)it * 256 + 4 * lane) = c; } }
}
__device__ __forceinline__ size_t ka_off(int bh, int s, int d) { return (size_t)bh * S * 96 + (size_t)(s >> 5) * 3072 + (d >> 3) * 256 + (s & 31) * 8 + (d & 7); }
__device__ __forceinline__ size_t km_off(int bh, int s, int d) { return (size_t)bh * S * 64 + (size_t)(s >> 5) * 2048 + (d >> 3) * 256 + (s & 31) * 8 + (d & 7); }
__device__ __forceinline__ size_t vf_off(int bh, int key, int dv) { return (size_t)bh * S * 64 + (size_t)(key >> 5) * 2048 + ((((dv >> 5) * 2 + ((key >> 4) & 1)) * 2 + ((key >> 2) & 1)) * 256) + (dv & 31) * 8 + ((key >> 3) & 1) * 4 + (key & 3); }
template <int NKS> __device__ __forceinline__ void attn_load(const bf16_t* Kb, const bf16_t* Vb, int kt, int lane, bf16x8 (&kf)[NKS], bf16x8 (&vf)[4]) {
    const bf16_t* kp = Kb + (size_t)kt * (512 * NKS) + lane * 8; const bf16_t* vp = Vb + (size_t)kt * 2048 + lane * 8;
#pragma unroll
    for (int ks = 0; ks < NKS; ++ks) kf[ks] = *(const bf16x8*)(kp + ks * 512);
#pragma unroll
    for (int i = 0; i < 4; ++i) vf[i] = *(const bf16x8*)(vp + i * 512);
}
__device__ __forceinline__ float max3f_nop(float a, float b, float c) { float r; asm volatile("s_nop 15\n\ts_nop 3\n\tv_max3_f32 %0, %1, %2, %3" : "=v"(r) : "v"(a), "v"(b), "v"(c)); return r; }
__device__ __forceinline__ float max3f_(float a, float b, float c) { float r; asm volatile("v_max3_f32 %0, %1, %2, %3" : "=v"(r) : "v"(a), "v"(b), "v"(c)); return r; }
__device__ __forceinline__ float max2f_(float a, float b) { float r; asm volatile("v_max_f32_e32 %0, %1, %2" : "=v"(r) : "v"(a), "v"(b)); return r; }
template <int NKS> __device__ __forceinline__ void attn_tile(const bf16x8 (&kf)[NKS], const bf16x8 (&vf)[4], const bf16x8 (&qf)[NKS], bool diag, bool act, int r, int h, f32x16& O0, f32x16& O1, float& m, float& l) {
    f32x16 X;
#pragma unroll
    for (int i = 0; i < 16; ++i) X[i] = 0.f;
#pragma unroll
    for (int ks = 0; ks < NKS; ++ks) X = __builtin_amdgcn_mfma_f32_32x32x16_bf16(kf[ks], qf[ks], X, 0, 0, 0);
    if (diag) {
#pragma unroll
        for (int i = 0; i < 16; ++i) if ((i & 3) + 8 * (i >> 2) + 4 * h > r) X[i] = NEG_INF;
    }
    if (__ballot(!act) != 0ull) {
#pragma unroll
        for (int i = 0; i < 16; ++i) X[i] = act ? X[i] : NEG_INF;
    }
    float mx;
    { const float t0 = max3f_nop(X[0], X[1], X[2]), t1 = max3f_(X[3], X[4], X[5]), t2 = max3f_(X[6], X[7], X[8]), t3 = max3f_(X[9], X[10], X[11]), t4 = max3f_(X[12], X[13], X[14]);
      mx = max2f_(max3f_(t0, t1, X[15]), max3f_(t2, t3, t4)); }
    { const u32x2 pr = __builtin_amdgcn_permlane32_swap(__float_as_uint(mx), __float_as_uint(mx), false, false);
      mx = max2f_(__uint_as_float(pr[0]), __uint_as_float(pr[1])); }
    const float m_old = m; const float mn = max2f_(m, mx), ms = (mn == NEG_INF) ? 0.f : mn, al = __builtin_amdgcn_exp2f(m - ms); m = mn;
    f32x2 s2[4];
#pragma unroll
    for (int i = 0; i < 8; ++i) { const f32x2 d = (f32x2){X[2 * i], X[2 * i + 1]} - (f32x2){ms, ms}; X[2 * i] = __builtin_amdgcn_exp2f(d[0]); X[2 * i + 1] = __builtin_amdgcn_exp2f(d[1]); }
#pragma unroll
    for (int i = 0; i < 4; ++i) s2[i] = (f32x2){X[4 * i], X[4 * i + 1]} + (f32x2){X[4 * i + 2], X[4 * i + 3]};
    const f32x2 s1 = (s2[0] + s2[1]) + (s2[2] + s2[3]);
    const float ps = s1[0] + s1[1];
    l = l * al + ps;
    if (__ballot(mn != m_old) != 0ull) {
#pragma unroll
        for (int i = 0; i < 16; ++i) { O0[i] *= al; O1[i] *= al; }
    }
    bf16x8 p0, p1;
    { u32x4 w; w.x = cvt_pk_bf16(X[0], X[1]); w.y = cvt_pk_bf16(X[2], X[3]); w.z = cvt_pk_bf16(X[4], X[5]); w.w = cvt_pk_bf16(X[6], X[7]); p0 = __builtin_bit_cast(bf16x8, w);
      w.x = cvt_pk_bf16(X[8], X[9]); w.y = cvt_pk_bf16(X[10], X[11]); w.z = cvt_pk_bf16(X[12], X[13]); w.w = cvt_pk_bf16(X[14], X[15]); p1 = __builtin_bit_cast(bf16x8, w); }
    O0 = __builtin_amdgcn_mfma_f32_32x32x16_bf16(vf[0], p0, O0, 0, 0, 0);
    O0 = __builtin_amdgcn_mfma_f32_32x32x16_bf16(vf[1], p1, O0, 0, 0, 0);
    O1 = __builtin_amdgcn_mfma_f32_32x32x16_bf16(vf[2], p0, O1, 0, 0, 0);
    O1 = __builtin_amdgcn_mfma_f32_32x32x16_bf16(vf[3], p1, O1, 0, 0, 0);
}
__device__ __forceinline__ void attn_store(bf16_t* yrow, int h, const f32x16& O0, const f32x16& O1, float l) {
    const float inv = __builtin_amdgcn_rcpf(l + __shfl_xor(l, 32));
#pragma unroll
    for (int g = 0; g < 4; ++g) { u32x2 w; w.x = cvt_pk_bf16(O0[4 * g] * inv, O0[4 * g + 1] * inv); w.y = cvt_pk_bf16(O0[4 * g + 2] * inv, O0[4 * g + 3] * inv); *(u32x2*)(yrow + 8 * g + 4 * h) = w;
        u32x2 z; z.x = cvt_pk_bf16(O1[4 * g] * inv, O1[4 * g + 1] * inv); z.y = cvt_pk_bf16(O1[4 * g + 2] * inv, O1[4 * g + 3] * inv); *(u32x2*)(yrow + 32 + 8 * g + 4 * h) = z; }
}
__device__ __forceinline__ unsigned moba_select(const float* kmean_bh, const bf16x8 (&qf)[4], int blk, int h) {
    const float* kmean = kmean_bh + 8 * h;
    float g0 = NEG_INF, g1 = NEG_INF, g2 = NEG_INF; int i0 = -1, i1 = -1, i2 = -1;
    for (int jb = 0; jb < blk; ++jb) { float a = 0.f;
#pragma unroll
        for (int ks = 0; ks < 4; ++ks) { const f32x4 w0 = *(const f32x4*)(kmean + jb * 64 + 16 * ks), w1 = *(const f32x4*)(kmean + jb * 64 + 16 * ks + 4); const u32x4 qw = __builtin_bit_cast(u32x4, qf[ks]);
            a += bflo(qw.x) * w0[0] + bfhi(qw.x) * w0[1] + bflo(qw.y) * w0[2] + bfhi(qw.y) * w0[3] + bflo(qw.z) * w1[0] + bfhi(qw.z) * w1[1] + bflo(qw.w) * w1[2] + bfhi(qw.w) * w1[3]; }
        a += __shfl_xor(a, 32);
        if (a > g0) { g2 = g1; i2 = i1; g1 = g0; i1 = i0; g0 = a; i0 = jb; } else if (a > g1) { g2 = g1; i2 = i1; g1 = a; i1 = jb; } else if (a > g2) { g2 = a; i2 = jb; } }
    unsigned sel = 0u; if (i0 >= 0) sel |= 1u << i0; if (i1 >= 0) sel |= 1u << i1; if (i2 >= 0) sel |= 1u << i2;
    return sel;
}
template <int NKS, bool MOBA> __device__ __forceinline__ void attn_block(int bh, int qi, LAS unsigned char* lds, int tid, int wave, int lane) {
    unsigned char* ws = WSP(); const int r = lane & 31, h = lane >> 5, b = bh >> 2, hh = bh & 3, qt = 8 * qi + wave, q = qt * 32 + r;
    constexpr int DK = 16 * NKS, KCH = 64 * NKS  , TOT = KCH + 256;
    const bf16_t* Qp = (const bf16_t*)(ws + (MOBA ? WS_QM : WS_QA)) + ((size_t)bh * S + q) * DK + 8 * h;
    bf16x8 qf[NKS];
#pragma unroll
    for (int ks = 0; ks < NKS; ++ks) qf[ks] = *(const bf16x8*)(Qp + 16 * ks);
    unsigned sel = 0u;
    if (MOBA) sel = moba_select((const float*)(ws + WS_KMEAN) + (size_t)bh * 16 * 64, (const bf16x8 (&)[4])qf, qi, h);
    const bf16_t* Kb = (const bf16_t*)(ws + (MOBA ? WS_KM : WS_KA)) + (size_t)bh * S * DK; const bf16_t* Vb = (const bf16_t*)(ws + (MOBA ? WS_VTM : WS_VTA)) + (size_t)bh * S * 64;
    f32x16 O0, O1; ZERO16(O0); ZERO16(O1);
    float m = NEG_INF, l = 0.f;
    const int kt1 = 8 * qi + 8;
    const bool two = (tid + 512) < TOT;
    const int c0 = tid, c1 = two ? tid + 512 : tid + 512 - 256;
    const size_t off0 = (c0 < KCH) ? (size_t)c0 * 8 : (size_t)(c0 - KCH) * 8, off1 = (size_t)(c1 - KCH) * 8;
    const bf16_t* src0 = (c0 < KCH) ? Kb : Vb; const size_t tstep0 = (c0 < KCH) ? (size_t)(8 * KCH) : (size_t)2048;
    u32x4 g0, g1;
#define ATT_GLOAD(kt_) do { const int kc_ = ((kt_) < kt1) ? (kt_) : kt1 - 1; g0 = *(const u32x4*)(src0 + (size_t)kc_ * tstep0 + off0); g1 = *(const u32x4*)(Vb + (size_t)kc_ * 2048 + off1); } while (0)
#define ATT_LSTORE(buf_) do { *(LAS u32x4*)(lds + (buf_) * 16384 + c0 * 16) = g0; if (two) *(LAS u32x4*)(lds + (buf_) * 16384 + c1 * 16) = g1; } while (0)
    constexpr int NPFK = KCH / 8, NPF = NPFK + 32;
    unsigned pA = 0u, pB = 0u, pC = 0u, pD = 0u;
    const int pfl = tid % NPF; const char* pfsrc = (pfl < NPFK) ? (const char*)Kb + pfl * 128 : (const char*)Vb + (pfl - NPFK) * 128; const size_t pfstep = (pfl < NPFK) ? (size_t)(16 * KCH) : (size_t)4096;
#define ATT_PF(kt_, reg_) do { const int kc_ = ((kt_) < kt1) ? (kt_) : kt1 - 1; reg_ = *(const unsigned*)(pfsrc + (size_t)kc_ * pfstep); } while (0)
#define ATT_BAR() asm volatile("s_waitcnt lgkmcnt(0)\n\ts_barrier" ::: "memory")
#define ATT_STEP(kt_, reg_) do { const int kt = (kt_); const int cur = kt & 1; \
        asm volatile("" :: "v"(reg_)); \
        ATT_GLOAD(kt + 1); \
        ATT_PF(kt + 4, reg_); \
        bool act = true; \
        if (MOBA) { const int jb = kt >> 3; act = (jb == qi) || ((sel >> jb) & 1u); } \
        if (kt <= qt && __ballot(act) != 0ull) { \
            bf16x8 kf[NKS], vf[4]; const LAS unsigned char* base = lds + cur * 16384 + lane * 16; \
            _Pragma("unroll") for (int ks = 0; ks < NKS; ++ks) kf[ks] = *(const LAS bf16x8*)(base + ks * 1024); \
            _Pragma("unroll") for (int i = 0; i < 4; ++i) vf[i] = *(const LAS bf16x8*)(base + KCH * 16 + i * 1024); \
            attn_tile<NKS>(kf, vf, qf, kt == qt, act, r, h, O0, O1, m, l); \
        } \
        ATT_LSTORE(cur ^ 1); \
        ATT_BAR(); } while (0)
    __syncthreads();
    ATT_GLOAD(0); ATT_PF(1, pB); ATT_PF(2, pC); ATT_PF(3, pD); ATT_LSTORE(0);
    ATT_BAR();
    for (int kt4 = 0; kt4 < kt1; kt4 += 4) {
        ATT_STEP(kt4, pA); ATT_STEP(kt4 + 1, pB); ATT_STEP(kt4 + 2, pC); ATT_STEP(kt4 + 3, pD);
    }
    asm volatile("" :: "v"(pA), "v"(pB), "v"(pC), "v"(pD));
#undef ATT_PF
#undef ATT_BAR
#undef ATT_STEP
#undef ATT_GLOAD
#undef ATT_LSTORE
    attn_store((bf16_t*)(ws + WS_YCAT) + (size_t)(b * S + q) * DM + (MOBA ? 512 : 0) + hh * 64, h, O0, O1, l);
}

__device__ __forceinline__ void post_gla(const Params& p, int l, LAS unsigned char* lds, int tid) {
    const int hb = tid >> 8, t = tid & 255;
    LAS float* f = (LAS float*)lds + hb * GLA_HS; const GlaLds L{f, f + 1024, f + 1024 + 64 * 33, f + 1024 + 64 * 33 + 4096};
    LAS float* sqe = f + 1024 + 2 * 64 * 33 + 4096; LAS float* sqb = sqe + 64 * 33; LAS float* sst = sqb + 64 * 33; LAS float* srs = sst + 2048;
    const bf16_t* proj = (const bf16_t*)(WSP() + WS_PROJ); const float* gds = (const float*)(WSP() + WS_GDS); bf16_t* ycat = (bf16_t*)(WSP() + WS_YCAT);
    const float* hn = INP(I_GLA_HN) + l * 64;
    for (int it2 = blockIdx.x; it2 < 512; it2 += gridDim.x) {
        const int item = it2 * 2 + hb;
        gla_common_cached(item, L, t);
        const int h = item & 3, bn = item >> 2, b = bn >> 6, n = bn & 63, bh = b * 4 + h, r0 = bn * 64;
        { const int tt = t >> 2, d8 = (t & 3) * 8; const u32x4 w = *(const u32x4*)(proj + (size_t)(r0 + tt) * NPJ + h * 32 + d8);
          const float qv[8] = {bflo(w.x), bfhi(w.x), bflo(w.y), bfhi(w.y), bflo(w.z), bfhi(w.z), bflo(w.w), bfhi(w.w)};
#pragma unroll
          for (int e = 0; e < 8; ++e) { const int d = d8 + e; const float bb = L.sb[tt * 33 + d], br = 0.5f * L.sb[63 * 33 + d], q1 = qv[e] * 0.17677669529663687f;
              sqe[tt * 33 + d] = q1 * __expf(bb - br); sqb[tt * 33 + d] = q1 * __expf(bb); L.sk[tt * 33 + d] *= __expf(br - bb); } }
#pragma unroll
        for (int i = 0; i < 2; ++i) { const int c = t + 256 * i; *(LAS f32x4*)(sst + c * 4) = *(const f32x4*)(gds + (size_t)(bh * 64 + n) * 2048 + c * 4); }
        __syncthreads();
        f32x16 O; ZERO16(O);
        const int lane = tid & 63, wv = (tid >> 6) & 3, r = lane & 31, hf = lane >> 5, it = (wv >> 1) & 1, vt = wv & 1, i0 = 32 * it, v0 = 32 * vt;
        if (wv < 4) {
#define FRAG_ROW(dst, arr, rowstride, row, col0) do { float f_[8]; _Pragma("unroll") for (int e_ = 0; e_ < 8; ++e_) f_[e_] = arr[(row) * (rowstride) + (col0) + e_]; \
            u32x4 w_; w_.x = cvt_pk_safe(f_[0], f_[1]); w_.y = cvt_pk_safe(f_[2], f_[3]); w_.z = cvt_pk_safe(f_[4], f_[5]); w_.w = cvt_pk_safe(f_[6], f_[7]); dst = __builtin_bit_cast(bf16x8, w_); } while (0)
#define FRAG_COL(dst, arr, colstride, k0_, col) do { float f_[8]; _Pragma("unroll") for (int e_ = 0; e_ < 8; ++e_) f_[e_] = arr[((k0_) + 8 * (e_ >> 2) + (e_ & 3)) * (colstride) + (col)]; \
            u32x4 w_; w_.x = cvt_pk_safe(f_[0], f_[1]); w_.y = cvt_pk_safe(f_[2], f_[3]); w_.z = cvt_pk_safe(f_[4], f_[5]); w_.w = cvt_pk_safe(f_[6], f_[7]); dst = __builtin_bit_cast(bf16x8, w_); } while (0)
#pragma unroll
            for (int ks = 0; ks < 2; ++ks) { bf16x8 fa, fb; float f_[8];
#pragma unroll
                for (int e_ = 0; e_ < 8; ++e_) f_[e_] = sst[(16 * ks + 8 * hf + e_) * 64 + v0 + r];
                { u32x4 w_; w_.x = cvt_pk_safe(f_[0], f_[1]); w_.y = cvt_pk_safe(f_[2], f_[3]); w_.z = cvt_pk_safe(f_[4], f_[5]); w_.w = cvt_pk_safe(f_[6], f_[7]); fa = __builtin_bit_cast(bf16x8, w_); }
                FRAG_ROW(fb, sqb, 33, i0 + r, 16 * ks + 8 * hf);
                O = __builtin_amdgcn_mfma_f32_32x32x16_bf16(fa, fb, O, 0, 0, 0); }
            for (int jt = 0; jt <= it; ++jt) {
                f32x16 X; ZERO16(X);
#pragma unroll
                for (int ks = 0; ks < 2; ++ks) { bf16x8 fa, fb; FRAG_ROW(fa, L.sk, 33, 32 * jt + r, 16 * ks + 8 * hf); FRAG_ROW(fb, sqe, 33, i0 + r, 16 * ks + 8 * hf);
                    X = __builtin_amdgcn_mfma_f32_32x32x16_bf16(fa, fb, X, 0, 0, 0); }
                if (jt == it) {
#pragma unroll
                    for (int i = 0; i < 16; ++i) if ((i & 3) + 8 * (i >> 2) + 4 * hf > r) X[i] = 0.f;
                }
                bf16x8 p0, p1;
                { u32x4 w; w.x = cvt_pk_safe(X[0], X[1]); w.y = cvt_pk_safe(X[2], X[3]); w.z = cvt_pk_safe(X[4], X[5]); w.w = cvt_pk_safe(X[6], X[7]); p0 = __builtin_bit_cast(bf16x8, w);
                  w.x = cvt_pk_safe(X[8], X[9]); w.y = cvt_pk_safe(X[10], X[11]); w.z = cvt_pk_safe(X[12], X[13]); w.w = cvt_pk_safe(X[14], X[15]); p1 = __builtin_bit_cast(bf16x8, w); }
                bf16x8 va, vb; FRAG_COL(va, L.sv, 64, 32 * jt + 4 * hf, v0 + r); FRAG_COL(vb, L.sv, 64, 32 * jt + 16 + 4 * hf, v0 + r);
                O = __builtin_amdgcn_mfma_f32_32x32x16_bf16(va, p0, O, 0, 0, 0);
                O = __builtin_amdgcn_mfma_f32_32x32x16_bf16(vb, p1, O, 0, 0, 0);
            }
#undef FRAG_ROW
#undef FRAG_COL
            float ss = 0.f;
#pragma unroll
            for (int i = 0; i < 16; ++i) ss += O[i] * O[i];
            ss += __shfl_xor(ss, 32);
            if (hf == 0) srs[(it * 2 + vt) * 32 + r] = ss;
        }
        __syncthreads();
        if (wv < 4) {
            const float rs = __builtin_amdgcn_rsqf((srs[(it * 2) * 32 + r] + srs[(it * 2 + 1) * 32 + r]) * (1.f / 64.f) + EPS);
            const int row = r0 + i0 + r;
#pragma unroll
            for (int g4 = 0; g4 < 4; ++g4) { const int v = v0 + 8 * g4 + 4 * hf;
                const u32x2 gw = *(const u32x2*)(proj + (size_t)row * NPJ + 512 + h * 64 + v); const float g[4] = {bflo(gw.x), bfhi(gw.x), bflo(gw.y), bfhi(gw.y)};
                const f32x4 gn = *(const f32x4*)(hn + v); float y[4];
#pragma unroll
                for (int c = 0; c < 4; ++c) y[c] = O[4 * g4 + c] * rs * gn[c] * (g[c] * __builtin_amdgcn_rcpf(1.f + __expf(-g[c])));
                u32x2 w; w.x = cvt_pk_safe(y[0], y[1]); w.y = cvt_pk_safe(y[2], y[3]); *(u32x2*)(ycat + (size_t)row * DM + 256 + h * 64 + v) = w; }
        }
        __syncthreads();
    }
}
__device__ __forceinline__ void post_lru(const Params& p, int gtid, int gthreads) {
    const float* lra = (const float*)(WSP() + WS_LRA); const float* lru = (const float*)(WSP() + WS_LRU); const float* carry = (const float*)(WSP() + WS_CARRY);
    const bf16_t* proj = (const bf16_t*)(WSP() + WS_PROJ); bf16_t* ycat = (bf16_t*)(WSP() + WS_YCAT);
    for (int idx = gtid; idx < 4 * 256 * 256; idx += gthreads) {
        const int ch = idx & 255, c16 = (idx >> 8) & 255, b = idx >> 16; float hcur = carry[(size_t)(b * 256 + ch) * 256 + c16];
        const int r0 = b * S + c16 * 16;
        float av[16], uv[16], gv[16];
#pragma unroll
        for (int t = 0; t < 16; ++t) { const size_t o = (size_t)(r0 + t) * 256 + ch; av[t] = lra[o]; uv[t] = lru[o]; gv[t] = bf2f(proj[(size_t)(r0 + t) * NPJ + 1024 + ch]); }
#pragma unroll
        for (int t = 0; t < 16; ++t) { hcur = av[t] * hcur + uv[t]; ycat[(size_t)(r0 + t) * DM + 768 + ch] = (bf16_t)f2bf(hcur * gelu_tanh(gv[t])); }
    }
}
__device__ __forceinline__ void final_norm(const Params& p, int gwave, int gwaves, int lane) {
    float* out = OUTP(); const float* g = INP(I_FINAL_NORM);
    f32x4 gv[4];
#pragma unroll
    for (int j = 0; j < 4; ++j) gv[j] = ((const f32x4*)g)[64 * j + lane];
    for (int r2 = gwave; r2 < T / 2; r2 += gwaves) { f32x4 v[2][4];
#pragma unroll
        for (int u = 0; u < 2; ++u) { const f32x4* xr = (const f32x4*)(out + (size_t)(2 * r2 + u) * DM) + lane;
#pragma unroll
            for (int j = 0; j < 4; ++j) v[u][j] = xr[64 * j]; }
#pragma unroll
        for (int u = 0; u < 2; ++u) { f32x4* xr = (f32x4*)(out + (size_t)(2 * r2 + u) * DM) + lane; float s = 0.f;
#pragma unroll
            for (int j = 0; j < 4; ++j) s += sq4(v[u][j]);
            const float rs = __builtin_amdgcn_rsqf(wave_sum(s) * (1.f / 1024.f) + EPS);
#pragma unroll
            for (int j = 0; j < 4; ++j) xr[64 * j] = v[u][j] * rs * gv[j]; } }
}
#define TIDS int tid = threadIdx.x; asm volatile("" : "+v"(tid)); const int lane = tid & 63, wave = __builtin_amdgcn_readfirstlane(tid >> 6); \
    const int G = gridDim.x, gtid = blockIdx.x * 512 + tid, gthreads = G * 512, gwave = blockIdx.x * 8 + wave, gwaves = G * 8; (void)lane; (void)gtid; (void)gthreads; (void)gwave; (void)gwaves;
#ifdef DUP_SYNC
#define GSYNC() do { xcd_barrier(xbar); xcd_barrier(xbar); } while (0)
#else
#define GSYNC() xcd_barrier(xbar)
#endif
template <int l> __device__ __forceinline__ void layer_body(const Params& p, LAS unsigned char* lds, const XcdBarrier& xbar) {
#ifndef NO_P1
        { unsigned char* ws = WSP(); pg8::Gemm g{(const bf16_t*)(ws + WS_XBF), (const bf16_t*)(ws + WS_WIN) + (size_t)l * NIN * DM, T, NIN, DM}; pg8::StaticOrder so; so.init(T, NIN, (int)gridDim.x, (int)blockIdx.x);
          EpiIn E{ws};
          pg8::gemm_phase<EpiIn, pg8::StaticOrder, true, true>(lds, g, so, E);
#ifdef DUP_P1
          __syncthreads(); pg8::gemm_phase<EpiIn, pg8::StaticOrder, true, true>(lds, g, so, E);
#endif
        }
#endif
        GSYNC();
#ifndef NO_MID
        { TIDS; mid_mla(p, gtid, gthreads); mid_kmean(p, lds, tid); mid_gla(p, l, lds, tid); mid_lru(p, l, lds, tid); }
#ifdef DUP_MIDG
        { TIDS; mid_gla(p, l, lds, tid); }
#endif
#ifdef DUP_MIDL
        { TIDS; mid_lru(p, l, lds, tid); }
#endif
#endif
        if (l == 1) { TIDS; convert_ffn_weights(p, 1, lds, gwave, gwaves, wave, lane); }
        GSYNC();
        { TIDS; seq_scans(p, lds, tid, gwave, gwaves, lane);
          asm volatile("s_waitcnt vmcnt(0)" ::: "memory"); __syncthreads();
          if (tid == 0) { __builtin_amdgcn_fence(__ATOMIC_RELEASE, "agent"); asm volatile("s_waitcnt vmcnt(0)" ::: "memory");
                          __hip_atomic_fetch_add((unsigned*)(WSP() + WS_LRW + 36864) + 64 * l, 1u, __ATOMIC_RELAXED, __HIP_MEMORY_SCOPE_AGENT); }
#ifndef NO_ATT
          { const int x = blockIdx.x & 7, j = blockIdx.x >> 3, bh = 2 * x + (j & 1), qi = j >> 1;
            attn_block<6, false>(bh, qi, lds, tid, wave, lane); attn_block<4, true>(bh, 15 - qi, lds, tid, wave, lane);
#ifdef DUP_ATT
            attn_block<6, false>(bh, qi, lds, tid, wave, lane); attn_block<4, true>(bh, 15 - qi, lds, tid, wave, lane);
#endif
          }
#endif
          if (tid == 0) { unsigned sp = 0u; while (__hip_atomic_load((unsigned*)(WSP() + WS_LRW + 36864) + 64 * l, __ATOMIC_RELAXED, __HIP_MEMORY_SCOPE_AGENT) < gridDim.x) { __builtin_amdgcn_s_sleep(2); if (++sp > (1u << 22)) break; }
                          __builtin_amdgcn_fence(__ATOMIC_ACQUIRE, "agent"); asm volatile("s_waitcnt vmcnt(0)" ::: "memory"); }
          __syncthreads();
        }
#ifndef NO_POST
        { TIDS; post_gla(p, l, lds, tid); post_lru(p, gtid, gthreads); }
#ifdef DUP_POST
        { TIDS; post_gla(p, l, lds, tid); post_lru(p, gtid, gthreads); }
#endif
#endif
        GSYNC();
#ifndef NO_P5
        { unsigned char* ws = WSP(); pg8::Gemm g{(const bf16_t*)(ws + WS_YCAT), (const bf16_t*)(ws + WS_WOUT) + (size_t)l * DM * DM, T, DM, DM}; pg8::StaticOrder so; so.init(T, DM, (int)gridDim.x, (int)blockIdx.x);
          EpiRes E{(l == 0) ? INP(I_X) : (const float*)OUTP(), OUTP(), ws};
          pg8::gemm_phase<EpiRes, pg8::StaticOrder, true, true>(lds, g, so, E); }
#endif
        GSYNC();
#ifndef NO_P6
        { unsigned char* ws = WSP(); pg8::Gemm g{(const bf16_t*)(ws + WS_XBF), (const bf16_t*)(ws + WS_WFI), T, NFI, DM}; pg8::StaticOrder so; so.init(T, NFI, (int)gridDim.x, (int)blockIdx.x);
          EpiSwi E{ws};
          pg8::gemm_phase<EpiSwi, pg8::StaticOrder, true, true>(lds, g, so, E);
#ifdef DUP_P6
          __syncthreads(); pg8::gemm_phase<EpiSwi, pg8::StaticOrder, true, true>(lds, g, so, E);
#endif
        }
#endif
        GSYNC();
#ifndef NO_P7
        { unsigned char* ws = WSP(); pg8::Gemm g{(const bf16_t*)(ws + WS_ACT), (const bf16_t*)(ws + WS_WFO), T, DM, FF}; pg8::StaticOrder so; so.init(T, DM, (int)gridDim.x, (int)blockIdx.x);
          if (l == 1) { EpiResFinal E{(const float*)OUTP(), OUTP(), INP(I_FINAL_NORM), (float*)(ws + WS_SSX), (unsigned*)(ws + WS_LRW + 16384)};
                        pg8::gemm_phase<EpiResFinal, pg8::StaticOrder, true, true>(lds, g, so, E); }
          else { EpiRes E{(const float*)OUTP(), OUTP(), ws};
                 pg8::gemm_phase<EpiRes, pg8::StaticOrder, true, true>(lds, g, so, E); } }
#endif
        if (l == 0) GSYNC();
    }
__global__ void __launch_bounds__(512) mega_fwd(Params p) {
    extern __shared__ __attribute__((aligned(16))) unsigned char lds_raw[];
    LAS unsigned char* lds = (LAS unsigned char*)lds_raw;
    cg::grid_group grid = cg::this_grid();
    (void)p;
    if (threadIdx.x < 4) ((volatile LAS unsigned*)(lds + 131072))[threadIdx.x] = 0u;
    __syncthreads();
    const XcdBarrier xbar = xcd_barrier_post((unsigned*)(WSP() + WS_LRW), (volatile LAS unsigned*)(lds + 131072));
    { TIDS; fuse_weights(lds, tid); }
    { TIDS; prologue_a(p, gtid, gthreads, gwave, gwaves, lane); }
    if (gridDim.x == 0x7fffffffu) grid.sync();
    GSYNC();
    { TIDS; prologue_b(p, lds, gwave, gwaves, wave, lane); }
    GSYNC();
#ifdef DUP_PRO
    { TIDS; prologue_a(p, gtid, gthreads, gwave, gwaves, lane); }
    GSYNC();
    { TIDS; prologue_b(p, lds, gwave, gwaves, wave, lane); }
    GSYNC();
#endif
    layer_body<0>(p, lds, xbar);
    layer_body<1>(p, lds, xbar);
}
}

extern "C" void kernel_launch(void* const* d_in, const int* in_sizes, int n_in, void* d_out, int out_size, void* d_ws, size_t ws_size, hipStream_t stream) {
    static int grid = 0;
    if (grid == 0) {
        if (n_in != 22 || ws_size < mk::WS_END) { fprintf(stderr, "kernel_launch: unexpected inputs (n_in %d, ws %zu)\n", n_in, ws_size); grid = -1; return; }
        int dev = 0, cus = 0, per_cu = 0;
        hipGetDevice(&dev); hipDeviceGetAttribute(&cus, hipDeviceAttributeMultiprocessorCount, dev);
        if (hipFuncSetAttribute((const void*)mk::mega_fwd, hipFuncAttributeMaxDynamicSharedMemorySize, mk::LDS_BYTES) != hipSuccess) { fprintf(stderr, "kernel_launch: hipFuncSetAttribute failed\n"); grid = -1; return; }
        if (hipOccupancyMaxActiveBlocksPerMultiprocessor(&per_cu, (const void*)mk::mega_fwd, 512, mk::LDS_BYTES) != hipSuccess || per_cu < 1) per_cu = 1;
        (void)hipGetLastError();
        grid = cus * per_cu;
        if (grid != 256) { fprintf(stderr, "kernel_launch: this kernel needs a 256-workgroup grid (got %d)\n", grid); grid = -1; return; }
    }
    if (grid < 0) return;
    mk::Params p{};
    for (int i = 0; i < 22; ++i) p.in[i] = (const float*)d_in[i];
    p.out = (float*)d_out; p.ws = (unsigned char*)d_ws;
    if (hipMemsetAsync((char*)d_ws + mk::WS_LRW, 0, 49152, stream) != hipSuccess) { fprintf(stderr, "kernel_launch: memset of the barrier words failed\n"); return; }
    void* args[] = {&p};
    hipError_t e = hipLaunchCooperativeKernel((const void*)mk::mega_fwd, dim3(grid), dim3(512), args, mk::LDS_BYTES, stream);
    if (e != hipSuccess) fprintf(stderr, "cooperative launch failed: %s (grid %d)\n", hipGetErrorString(e), grid);
}
```

```cpp
#include <hip/hip_runtime.h>
#include <hip/hip_cooperative_groups.h>
#include <cstdio>
#include <cstdint>
#include <cmath>
namespace cg = cooperative_groups;
namespace pg8 {
#define PG8_LAS __attribute__((address_space(3)))
typedef unsigned short bf16_t;
typedef short bf16x8 __attribute__((ext_vector_type(8)));
typedef float f32x4 __attribute__((ext_vector_type(4)));
typedef unsigned u32x4 __attribute__((ext_vector_type(4)));
constexpr int BM = 256, BK = 64, HALF = 128, HTB = HALF * BK * 2  , STAGE_BYTES = 8 * HTB, NXCD = 8, WGM = 5;

__host__ __device__ __forceinline__ int lds_byte(int r, int c) { const int st = (r >> 4) * 2 + (c >> 5), rr = r & 15, cc = c & 31, ob = rr * 64 + cc * 2; return st * 1024 + (ob ^ (((ob >> 9) & 1) << 5)); }
__host__ __device__ __forceinline__ void stage_rc(int b, int& R, int& C) { const int st = b / 1024, sb = b % 1024, swz = sb ^ (((sb >> 9) & 1) << 5); R = (st >> 1) * 16 + swz / 64; C = (st & 1) * 32 + (swz % 64) / 2; }
__host__ __device__ __forceinline__ int perm32(int rho) { const int n = rho >> 4, i = rho & 15; return 8 * (i >> 2) + 4 * n + (i & 3); }

struct Unit { int pm, pn; };
struct Gemm { const bf16_t* A; const bf16_t* Bt; int M, N, K; };

struct StaticOrder {
    int nM, nN, nwg, G, c;
    __host__ __device__ void init(int M, int N, int G_, int c_) { nM = M / BM; nN = N / BM; nwg = nM * nN; G = G_; c = c_; }
    __host__ __device__ bool next(int i, Unit& u) const {
        const long L = (long)i * G + c; if (L >= nwg) return false;
        int wgid = (int)L; { const int q = nwg / NXCD, r = nwg % NXCD, xcd = wgid % NXCD, off = wgid / NXCD; wgid = (xcd < r ? xcd * (q + 1) : r * (q + 1) + (xcd - r) * q) + off; }
        const int nig = WGM * nN, gid = wgid / nig, fm = gid * WGM, gsz = (nM - fm) < WGM ? (nM - fm) : WGM;
        u.pm = fm + ((wgid % nig) % gsz); u.pn = (wgid % nig) / gsz; return true;
    }
    __device__ __forceinline__ void a_ready(const Unit&) const {}
    __device__ __forceinline__ void done(const Unit&) const {}
};

__device__ __forceinline__ unsigned cvt_pk_bf16(float lo, float hi) { unsigned r; asm volatile("v_cvt_pk_bf16_f32 %0, %1, %2" : "=v"(r) : "v"(lo), "v"(hi)); return r; }
template <class Epi, class Sched, bool ALIGN_EPI = false, bool SP2 = false>
__device__ __forceinline__ void gemm_phase(PG8_LAS unsigned char* lds, const Gemm g, const Sched& S, const Epi& E) {
    int tid_ = threadIdx.x; asm volatile("" : "+v"(tid_));
    const int tid = tid_, wid = __builtin_amdgcn_readfirstlane(tid >> 6), lane = tid & 63, wr = wid >> 2, wc = wid & 3, fr = lane & 15, fq = lane >> 4;
    const int K = g.K, nt = K / BK;
    unsigned voffA[2], voffB[2];
#pragma unroll
    for (int i = 0; i < 2; ++i) { int R, C; stage_rc(tid * 16 + i * 8192, R, C); const int Rb = Epi::PERM ? ((R & ~31) + perm32(R & 31)) : R;
        voffA[i] = (unsigned)(R * K + C) * 2u; voffB[i] = (unsigned)(Rb * K + C) * 2u; }
    const size_t kstep = (size_t)(BK * 2);
    const size_t hstep = (size_t)HALF * K * 2;
    const size_t tstep = 2 * hstep;
    const unsigned ldsw = (unsigned)wid * 1024u;
    const int aoff = lds_byte(wr * 64 + fr, fq * 8), boff = lds_byte(wc * 32 + fr, fq * 8);
#define PG8_SA(b, h) (((b) * 2 + (h)) * HTB)
#define PG8_SB(b, h) ((4 + (b) * 2 + (h)) * HTB)
#define PG8_STAGE(bufoff, gbase, voff) do { _Pragma("unroll") for (int _i = 0; _i < 2; ++_i) \
        __builtin_amdgcn_global_load_lds((const unsigned*)((const char*)(gbase) + (voff)[_i]), (PG8_LAS unsigned*)(lds + (bufoff) + ldsw + _i * 8192), 16, 0, 0); } while (0)
#define PG8_LDA(dst, b, h) do { _Pragma("unroll") for (int m = 0; m < 4; ++m) _Pragma("unroll") for (int k = 0; k < 2; ++k) dst[m][k] = *(const PG8_LAS bf16x8*)(lds + PG8_SA(b, h) + aoff + m * 2048 + k * 1024); } while (0)
#define PG8_LDB(dst, b, h) do { _Pragma("unroll") for (int n = 0; n < 2; ++n) _Pragma("unroll") for (int k = 0; k < 2; ++k) dst[n][k] = *(const PG8_LAS bf16x8*)(lds + PG8_SB(b, h) + boff + n * 2048 + k * 1024); } while (0)
#define PG8_MMA(ai, bj, At, Bt) do { __builtin_amdgcn_s_setprio(1); _Pragma("unroll") for (int m = 0; m < 4; ++m) _Pragma("unroll") for (int n = 0; n < 2; ++n) _Pragma("unroll") for (int k = 0; k < 2; ++k) \
        acc[ai][bj][m][n] = __builtin_amdgcn_mfma_f32_16x16x32_bf16(Bt[n][k], At[m][k], acc[ai][bj][m][n], 0, 0, 0); __builtin_amdgcn_s_setprio(0); } while (0)
#define PG8_WAIT_V(n) asm volatile("s_waitcnt vmcnt(" #n ")" ::: "memory")
#define PG8_WAIT_L(n) asm volatile("s_waitcnt lgkmcnt(" #n ")" ::: "memory")
#define PG8_BAR __builtin_amdgcn_s_barrier()
#define PG8_SCHED __builtin_amdgcn_sched_barrier(0)
    Unit cur, nxt; int ui = 0;
    if (!S.next(0, cur)) return;
    f32x4 acc[2][2][4][2];
#pragma unroll
    for (int a = 0; a < 2; ++a)
#pragma unroll
        for (int b = 0; b < 2; ++b)
#pragma unroll
            for (int m = 0; m < 4; ++m)
#pragma unroll
                for (int n = 0; n < 2; ++n) acc[a][b][m][n] = (f32x4){0.f, 0.f, 0.f, 0.f};
    bf16x8 At[4][2], B0[2][2], B1[2][2];
    const char* cA = (const char*)g.A + (size_t)cur.pm * tstep; const char* cB = (const char*)g.Bt + (size_t)cur.pn * tstep;
    S.a_ready(cur);
    if constexpr (SP2) {
        PG8_STAGE(PG8_SB(0, 0), cB, voffB); PG8_STAGE(PG8_SB(0, 1), cB + hstep, voffB); PG8_STAGE(PG8_SA(0, 0), cA, voffA); PG8_STAGE(PG8_SA(0, 1), cA + hstep, voffA);
        if (wr == 1) PG8_BAR;
        PG8_WAIT_V(2); PG8_BAR;
        PG8_STAGE(PG8_SB(1, 0), cB + kstep, voffB); PG8_STAGE(PG8_SA(1, 0), cA + kstep, voffA); PG8_STAGE(PG8_SB(1, 1), cB + hstep + kstep, voffB);
        PG8_WAIT_V(6); PG8_BAR;
    } else {
        PG8_STAGE(PG8_SB(0, 0), cB, voffB); PG8_STAGE(PG8_SA(0, 0), cA, voffA); PG8_STAGE(PG8_SB(0, 1), cB + hstep, voffB); PG8_STAGE(PG8_SA(0, 1), cA + hstep, voffA);
        if (wr == 1) PG8_BAR;
        PG8_WAIT_V(4); PG8_BAR;
        PG8_STAGE(PG8_SB(1, 0), cB + kstep, voffB); PG8_STAGE(PG8_SA(1, 0), cA + kstep, voffA); PG8_STAGE(PG8_SB(1, 1), cB + hstep + kstep, voffB);
        PG8_WAIT_V(6); PG8_BAR;
    }
    for (;;) {
        const bool has_next = S.next(ui + 1, nxt);
        const char* nA = has_next ? (const char*)g.A + (size_t)nxt.pm * tstep : cA; const char* nB = has_next ? (const char*)g.Bt + (size_t)nxt.pn * tstep : cB;
        for (int t = 0; t < nt; t += 2) {
            const bool last = (t == nt - 2);
            const char* a1 = cA + (size_t)(t + 1) * kstep;
            const char* a2 = last ? nA : cA + (size_t)(t + 2) * kstep; const char* b2 = last ? nB : cB + (size_t)(t + 2) * kstep;
            const char* a3 = a2 + kstep; const char* b3 = b2 + kstep;
            if (last && has_next) S.a_ready(nxt);
            if constexpr (SP2) {
            PG8_LDB(B0, 0, 0); PG8_LDB(B1, 0, 1); PG8_SCHED; PG8_LDA(At, 0, 0); PG8_STAGE(PG8_SA(1, 1), a1 + hstep, voffA);
            PG8_WAIT_V(8); PG8_WAIT_L(0); PG8_BAR; PG8_MMA(0, 0, At, B0); PG8_MMA(0, 1, At, B1); PG8_BAR; PG8_SCHED;
            PG8_LDA(At, 0, 1); PG8_STAGE(PG8_SB(0, 0), b2, voffB); PG8_STAGE(PG8_SB(0, 1), b2 + hstep, voffB); PG8_STAGE(PG8_SA(0, 0), a2, voffA);
            PG8_WAIT_V(8); PG8_WAIT_L(0); PG8_BAR; PG8_MMA(1, 0, At, B0); PG8_MMA(1, 1, At, B1); PG8_BAR; PG8_SCHED;
            PG8_LDB(B0, 1, 0); PG8_LDB(B1, 1, 1); PG8_SCHED; PG8_LDA(At, 1, 0); PG8_STAGE(PG8_SA(0, 1), a2 + hstep, voffA);
            PG8_WAIT_V(8); PG8_WAIT_L(0); PG8_BAR; PG8_MMA(0, 0, At, B0); PG8_MMA(0, 1, At, B1); PG8_BAR; PG8_SCHED;
            PG8_LDA(At, 1, 1); PG8_STAGE(PG8_SB(1, 0), b3, voffB); PG8_STAGE(PG8_SB(1, 1), b3 + hstep, voffB); PG8_STAGE(PG8_SA(1, 0), a3, voffA);
            PG8_WAIT_V(8); PG8_WAIT_L(0); PG8_BAR; PG8_MMA(1, 0, At, B0); PG8_MMA(1, 1, At, B1); PG8_BAR; PG8_SCHED;
            } else {
            PG8_LDB(B0, 0, 0); PG8_SCHED; PG8_LDA(At, 0, 0); PG8_STAGE(PG8_SA(1, 1), a1 + hstep, voffA);
            PG8_WAIT_L(8); PG8_BAR; PG8_WAIT_L(0); PG8_MMA(0, 0, At, B0); PG8_BAR; PG8_SCHED;
            PG8_LDB(B1, 0, 1); PG8_STAGE(PG8_SB(0, 0), b2, voffB);
            PG8_BAR; PG8_WAIT_L(0); PG8_MMA(0, 1, At, B1); PG8_BAR;
            PG8_LDA(At, 0, 1); PG8_STAGE(PG8_SA(0, 0), a2, voffA);
            PG8_BAR; PG8_WAIT_L(0); PG8_MMA(1, 0, At, B0); PG8_BAR; PG8_SCHED;
            PG8_STAGE(PG8_SB(0, 1), b2 + hstep, voffB);
            PG8_WAIT_V(6); PG8_BAR; PG8_MMA(1, 1, At, B1); PG8_BAR;
            PG8_LDB(B0, 1, 0); PG8_SCHED; PG8_LDA(At, 1, 0); PG8_STAGE(PG8_SA(0, 1), a2 + hstep, voffA);
            PG8_WAIT_L(8); PG8_BAR; PG8_WAIT_L(0); PG8_MMA(0, 0, At, B0); PG8_BAR; PG8_SCHED;
            PG8_LDB(B1, 1, 1); PG8_STAGE(PG8_SB(1, 0), b3, voffB);
            PG8_BAR; PG8_WAIT_L(0); PG8_MMA(0, 1, At, B1); PG8_BAR;
            PG8_LDA(At, 1, 1); PG8_STAGE(PG8_SA(1, 0), a3, voffA);
            PG8_BAR; PG8_WAIT_L(0); PG8_MMA(1, 0, At, B0); PG8_BAR; PG8_SCHED;
            PG8_STAGE(PG8_SB(1, 1), b3 + hstep, voffB);
            PG8_WAIT_V(6); PG8_BAR; PG8_MMA(1, 1, At, B1); PG8_BAR;
            }
        }
        if constexpr (ALIGN_EPI) { if (wr == 0) PG8_BAR; }
        if constexpr (!Epi::AFTER_DRAIN) { E(acc, cur, wr, wc, fr, fq); S.done(cur); }
        if (!has_next) break;
#pragma unroll
        for (int a = 0; a < 2; ++a)
#pragma unroll
            for (int b = 0; b < 2; ++b)
#pragma unroll
                for (int m = 0; m < 4; ++m)
#pragma unroll
                    for (int n = 0; n < 2; ++n) acc[a][b][m][n] = (f32x4){0.f, 0.f, 0.f, 0.f};
        cur = nxt; cA = nA; cB = nB; ++ui;
        if constexpr (ALIGN_EPI) { if (wr == 1) PG8_BAR; }
    }
    PG8_WAIT_V(0);
    if constexpr (!ALIGN_EPI) { if (wr == 0) PG8_BAR; }
    PG8_BAR;
    if constexpr (Epi::AFTER_DRAIN) { E.fused(acc, cur, wr, wc, fr, fq, lds, wid, lane); S.done(cur); }
#undef PG8_SA
#undef PG8_SB
#undef PG8_STAGE
#undef PG8_LDA
#undef PG8_LDB
#undef PG8_MMA
#undef PG8_WAIT_V
#undef PG8_WAIT_L
#undef PG8_BAR
#undef PG8_SCHED
}
}

namespace mk {
#define LAS __attribute__((address_space(3)))
using pg8::f32x4; using pg8::u32x4; using pg8::bf16_t; using pg8::Unit; using pg8::cvt_pk_bf16;
typedef float f32x2 __attribute__((ext_vector_type(2)));
typedef unsigned u32x2 __attribute__((ext_vector_type(2)));

constexpr int T = 16384, S = 4096, DM = 1024, NIN = 3584, NPJ = 1280, FF = 2816, NFI = 5632, INW = 2480;
constexpr float EPS = 1e-6f;
constexpr float LOG2E = 1.4426950408889634f;
constexpr float C_MLA = 0.10206207261596577f * LOG2E;
constexpr float C_MOBA = 0.125f * LOG2E;
constexpr float NEG_INF = -INFINITY;

constexpr size_t MiB = 1u << 20, KiB = 1024;
constexpr size_t WS_SSX = 0, WS_SSQ = 1 * MiB, WS_SSK = 1 * MiB + 256 * KiB, WS_KPGA = 1 * MiB + 512 * KiB, WS_ROPEA = 4 * MiB + 512 * KiB,
                 WS_ROPEM = 5 * MiB, WS_KMEAN = 5 * MiB + 256 * KiB, WS_GDEC = 5 * MiB + 512 * KiB, WS_AGGA = 6 * MiB, WS_AGGU = 7 * MiB, WS_CARRY = 8 * MiB,
                 WS_LRW = 9 * MiB,
                 WS_WIN = 10 * MiB, WS_WOUT = 24 * MiB, WS_WFI = 28 * MiB, WS_WFO = 39 * MiB, WS_XBF = 45 * MiB, WS_YCAT = 77 * MiB, WS_GDS = 109 * MiB,
                 WS_LRA = 117 * MiB, WS_LRU = 133 * MiB, WS_ACT = 149 * MiB, WS_PROJ = 149 * MiB, WS_QA = 189 * MiB, WS_KA = 201 * MiB, WS_VTA = 213 * MiB,
                 WS_QM = 221 * MiB, WS_KM = 229 * MiB, WS_VTM = 237 * MiB, WS_WFQ = 245 * MiB, WS_WFKV = 248 * MiB, WS_END = 254 * MiB;
constexpr int LDS_BYTES = 147456;

struct Params { const float* in[22]; float* out; unsigned char* ws; };
enum { I_X = 0, I_ATTN_NORM, I_W_IN, I_Q_NORM, I_W_UQ, I_KV_NORM, I_W_UKV, I_GLA_WA2, I_GLA_BA2, I_GLA_HN, I_CONV_W, I_CONV_B, I_LRU_WA, I_LRU_BA, I_LRU_WX, I_LRU_BX,
       I_LRU_LAM, I_W_OUT, I_FFN_NORM, I_W_FFN_IN, I_W_FFN_OUT, I_FINAL_NORM };

#define CAS __attribute__((address_space(4)))
__device__ __forceinline__ const float* INP(int i) { const CAS char* ka = (const CAS char*)__builtin_amdgcn_kernarg_segment_ptr(); asm volatile("" : "+s"(ka)); return *(const float* const CAS*)(ka + 8 * i); }
__device__ __forceinline__ float* OUTP() { return (float*)INP(22); }
__device__ __forceinline__ unsigned char* WSP() { return (unsigned char*)INP(23); }

__device__ __forceinline__ float bf2f(unsigned h) { return __uint_as_float(h << 16); }
__device__ __forceinline__ float bflo(unsigned w) { return __uint_as_float(w << 16); }
__device__ __forceinline__ float bfhi(unsigned w) { return __uint_as_float(w & 0xffff0000u); }

__device__ __forceinline__ float wave_sum(float v) {
#pragma unroll
    for (int o = 1; o < 64; o <<= 1) v += __shfl_xor(v, o);
    return v;
}
__device__ __forceinline__ float sigmoidf_(float z) { return __builtin_amdgcn_rcpf(1.f + __expf(-z)); }
__device__ __forceinline__ float logsigmoidf_(float z) { return fminf(z, 0.f) - __logf(1.f + __expf(-fabsf(z))); }
__device__ __forceinline__ float gelu_tanh(float x) { const float u = 0.7978845608028654f * (x + 0.044715f * x * x * x); const float t = 1.f - 2.f * __builtin_amdgcn_rcpf(__expf(2.f * u) + 1.f); return 0.5f * x * (1.f + t); }
__device__ __forceinline__ void store8(bf16_t* p, f32x4 a, f32x4 b) { u32x4 w; w.x = cvt_pk_bf16(a[0], a[1]); w.y = cvt_pk_bf16(a[2], a[3]); w.z = cvt_pk_bf16(b[0], b[1]); w.w = cvt_pk_bf16(b[2], b[3]); *(u32x4*)p = w; }
typedef __bf16 bf16x2_t __attribute__((ext_vector_type(2)));
__device__ __forceinline__ unsigned cvt_pk_safe(float lo, float hi) { const f32x2 v = {lo, hi}; const bf16x2_t b = __builtin_convertvector(v, bf16x2_t); return __builtin_bit_cast(unsigned, b); }
__device__ __forceinline__ unsigned pk2(float lo, float hi) { return cvt_pk_safe(lo, hi); }
__device__ __forceinline__ unsigned f2bf(float f) { return cvt_pk_safe(f, 0.f) & 0xffffu; }
__device__ __forceinline__ float sum4(f32x4 a) { return (a[0] + a[1]) + (a[2] + a[3]); }
__device__ __forceinline__ float sq4(f32x4 a) { return (a[0] * a[0] + a[1] * a[1]) + (a[2] * a[2] + a[3] * a[3]); }
__device__ __forceinline__ void load_rstd8(const float* ssx, int rbase, float (&rs)[2][4]) {
    f32x4 t[2][4];
#pragma unroll
    for (int ai = 0; ai < 2; ++ai)
#pragma unroll
        for (int m = 0; m < 4; ++m) t[ai][m] = *(const f32x4*)(ssx + (size_t)(rbase + ai * 128 + m * 16) * 4);
#pragma unroll
    for (int ai = 0; ai < 2; ++ai)
#pragma unroll
        for (int m = 0; m < 4; ++m) rs[ai][m] = __builtin_amdgcn_rsqf(sum4(t[ai][m]) * (1.f / 1024.f) + EPS);
}

#define XB_TMO      128
#define XB_XCNT(j)  (256  + 64 * (j))
#define XB_XSUB(j)  (1280 + 64 * (j))
#define XB_XGEN(j)  (2304 + 64 * (j))
#define XB_TOP      3328
#define XB_TOPGEN   3392
#define XCD_BAR_WORDS 3456
#define XB_SPIN_CAP (1u << 18)

__device__ __forceinline__ unsigned xb_ld(unsigned* p)              { return __hip_atomic_load(p, __ATOMIC_RELAXED, __HIP_MEMORY_SCOPE_AGENT); }
__device__ __forceinline__ unsigned xb_add(unsigned* p, unsigned v) { return __hip_atomic_fetch_add(p, v, __ATOMIC_RELAXED, __HIP_MEMORY_SCOPE_AGENT); }
__device__ __forceinline__ unsigned xb_xcc_id() { return (unsigned)__builtin_amdgcn_s_getreg((3 << 11) | 20) & 0xFu; }
#define XB_SPIN(cond, bar) do { unsigned _sp = 0; while (cond) { __builtin_amdgcn_s_sleep(1); \
    if ((++_sp & 255u) == 0u) { if (xb_ld(&(bar)[XB_TMO])) break; if (_sp > XB_SPIN_CAP) { atomicAdd(&(bar)[XB_TMO], 1u); break; } } } } while (0)

struct XcdBarrier {
    unsigned* bar; unsigned x;
    volatile LAS unsigned* st;
};

__device__ __forceinline__ XcdBarrier xcd_barrier_post(unsigned* bar, volatile LAS unsigned* st) {
    XcdBarrier b; b.bar = bar; b.x = xb_xcc_id(); b.st = st;
    if (threadIdx.x == 0) (void)xb_add(&bar[XB_XCNT(b.x)], 1u);
    return b;
}
__device__ __forceinline__ void xcd_barrier_complete(unsigned* bar, unsigned x, unsigned& nloc, unsigned& nx) {
    const unsigned G = gridDim.x * gridDim.y * gridDim.z;
    unsigned sum, cnt, mine, sp = 0u;
    for (;;) {
        sum = 0u; cnt = 0u; mine = 0u;
#pragma unroll
        for (unsigned j = 0; j < 16; ++j) { const unsigned c = xb_ld(&bar[XB_XCNT(j)]); sum += c; cnt += (c > 0u) ? 1u : 0u; mine = (j == x) ? c : mine; }
        if (sum == G) break;
        __builtin_amdgcn_s_sleep(1);
        if ((++sp & 255u) == 0u) { if (xb_ld(&bar[XB_TMO])) break; if (sp > XB_SPIN_CAP) { atomicAdd(&bar[XB_TMO], 1u); break; } }
    }
    nloc = mine > 0u ? mine : 1u; nx = cnt > 0u ? cnt : 1u;
}

__device__ __forceinline__ void xcd_barrier(const XcdBarrier& b) {
    asm volatile("s_waitcnt vmcnt(0)" ::: "memory");
    __syncthreads();
    if (threadIdx.x == 0) {
        unsigned* bar = b.bar;
        __builtin_amdgcn_s_waitcnt(0);
        unsigned nloc = b.st[0], nx = b.st[1];
        if (nloc == 0u) { xcd_barrier_complete(bar, b.x, nloc, nx); b.st[0] = nloc; b.st[1] = nx; }
        const unsigned old = xb_add(&bar[XB_XSUB(b.x)], 1u);
        const unsigned gen = old / nloc;
        if (old + 1u == (gen + 1u) * nloc) {
            __builtin_amdgcn_fence(__ATOMIC_RELEASE, "agent");
            asm volatile("s_waitcnt vmcnt(0)" ::: "memory");
            const unsigned og = xb_add(&bar[XB_TOP], 1u);
            const unsigned tg = og / nx;
            if (og + 1u == (tg + 1u) * nx) xb_add(&bar[XB_TOPGEN], 1u);
            else XB_SPIN(xb_ld(&bar[XB_TOPGEN]) == tg, bar);
            __builtin_amdgcn_fence(__ATOMIC_ACQUIRE, "agent");
            xb_add(&bar[XB_XGEN(b.x)], 1u);
            asm volatile("s_waitcnt vmcnt(0)" ::: "memory");
        } else {
            XB_SPIN(xb_ld(&bar[XB_XGEN(b.x)]) == gen, bar);
            __builtin_amdgcn_fence(__ATOMIC_ACQUIRE, "agent");
            asm volatile("s_waitcnt vmcnt(0)" ::: "memory");
        }
    }
    __syncthreads();
}

__device__ __forceinline__ size_t ka_off(int bh, int s, int d);
__device__ __forceinline__ size_t km_off(int bh, int s, int d);
__device__ __forceinline__ size_t vf_off(int bh, int key, int dv);
struct EpiIn {
    static constexpr bool PERM = true, AFTER_DRAIN = false;
    unsigned char* ws;
    __device__ __forceinline__ void operator()(const f32x4 (&acc)[2][2][4][2], const Unit& u, int wr, int wc, int fr_, int fq_) const {
        int fr = fr_, fq = fq_; asm volatile("" : "+v"(fr), "+v"(fq));
        const int pn = u.pn;
        const float* ssx = (const float*)(ws + WS_SSX); float* ssq = (float*)(ws + WS_SSQ); float* ssk = (float*)(ws + WS_SSK); float* kpga = (float*)(ws + WS_KPGA);
        bf16_t* Qa = (bf16_t*)(ws + WS_QA); bf16_t* Ka = (bf16_t*)(ws + WS_KA); bf16_t* Vta = (bf16_t*)(ws + WS_VTA); bf16_t* Qm = (bf16_t*)(ws + WS_QM); bf16_t* Km = (bf16_t*)(ws + WS_KM); bf16_t* Vtm = (bf16_t*)(ws + WS_VTM);
        bf16_t* proj = (bf16_t*)(ws + WS_PROJ); const float* ropeM = (const float*)(ws + WS_ROPEM);
        float rs8[2][4]; load_rstd8(ssx, u.pm * 256 + wr * 64 + fr, rs8);
#pragma unroll
        for (int ai = 0; ai < 2; ++ai)
#pragma unroll
            for (int m = 0; m < 4; ++m) {
                int r = u.pm * 256 + ai * 128 + wr * 64 + m * 16 + fr; asm volatile("" : "+v"(r));
                const float rs = rs8[ai][m];
                f32x4 v[2][2];
#pragma unroll
                for (int bj = 0; bj < 2; ++bj)
#pragma unroll
                    for (int n = 0; n < 2; ++n) v[bj][n] = acc[ai][bj][m][n] * rs;
                const int b = r >> 12, s = r & 4095;
                if (pn == 0) {
                    float q = (sq4(v[0][0]) + sq4(v[0][1])) + (sq4(v[1][0]) + sq4(v[1][1]));
                    q += __shfl_xor(q, 16); q += __shfl_xor(q, 32);
                    if (fq == 0) ssq[(size_t)r * 4 + wc] = q;
                } else if (pn == 1) {
                    float q = sq4(v[0][0]) + sq4(v[0][1]);
                    q += __shfl_xor(q, 16); q += __shfl_xor(q, 32);
                    if (fq == 0) ssk[(size_t)r * 4 + wc] = q;
                    if (wc == 0) { float* o = kpga + (size_t)r * 48 + 8 * fq; *(f32x4*)o = v[1][0]; *(f32x4*)(o + 4) = v[1][1]; }
                    else if (wc == 1 && fq < 2) { float* o = kpga + (size_t)r * 48 + 32 + 8 * fq; *(f32x4*)o = v[1][0]; *(f32x4*)(o + 4) = v[1][1]; }
                } else if (pn == 2) {
#pragma unroll
                    for (int bj = 0; bj < 2; ++bj) { const int h = 2 * bj + (wc >> 1), d0 = (wc & 1) * 32 + 8 * fq;
                        store8(Qa + ((size_t)(b * 4 + h) * S + s) * 96 + d0, v[bj][0], v[bj][1]); }
                } else if (pn == 4) {
#pragma unroll
                    for (int bj = 0; bj < 2; ++bj) { const int h = 2 * bj + (wc >> 1), d0 = (wc & 1) * 32 + 8 * fq;
                        store8(Ka + ka_off(b * 4 + h, s, d0), v[bj][0], v[bj][1]); }
                } else if (pn == 3) {
                    store8(Qa + ((size_t)(b * 4 + wc) * S + s) * 96 + 64 + 8 * fq, v[0][0], v[0][1]);
                    store8(proj + (size_t)r * NPJ + 32 * wc + 8 * fq, v[1][0], v[1][1]);
                } else if (pn == 5 || pn == 11) {
                    bf16_t* base = (pn == 5) ? Vta : Vtm;
#pragma unroll
                    for (int bj = 0; bj < 2; ++bj)
#pragma unroll
                        for (int n = 0; n < 2; ++n)
#pragma unroll
                            for (int i = 0; i < 4; ++i) { const int cl = 128 * bj + 32 * wc + 8 * fq + 4 * n + i; base[vf_off(b * 4 + (cl >> 6), s, cl & 63)] = (bf16_t)f2bf(v[bj][n][i]); }
                } else if (pn == 6) {
                    store8(proj + (size_t)r * NPJ + 128 + 32 * wc + 8 * fq, v[0][0], v[0][1]);
                } else if (pn == 9 || pn == 10) {
                    const float sc = (pn == 9) ? C_MOBA : 1.f;
                    const bool rot = ((wc & 1) == 0) && (fq < 2);
                    f32x4 cs = (f32x4){1.f, 1.f, 1.f, 1.f}, sn = (f32x4){0.f, 0.f, 0.f, 0.f};
                    if (rot) { cs = *(const f32x4*)(ropeM + (size_t)s * 8 + 4 * fq); sn = *(const f32x4*)(ropeM + (size_t)S * 8 + (size_t)s * 8 + 4 * fq); }
#pragma unroll
                    for (int bj = 0; bj < 2; ++bj) { const int h = 2 * bj + (wc >> 1), p0 = (wc & 1) * 32 + 8 * fq;
                        f32x4 x1 = v[bj][0], x2 = v[bj][1];
                        if (rot) { const f32x4 o1 = x1 * cs - x2 * sn, o2 = x2 * cs + x1 * sn; x1 = o1; x2 = o2; }
                        bf16_t* dst = (pn == 9) ? Qm + ((size_t)(b * 4 + h) * S + s) * 64 + p0 : Km + km_off(b * 4 + h, s, p0);
                        store8(dst, x1 * sc, x2 * sc); }
                } else {
                    const int off = (pn == 7) ? 256 : (pn == 8) ? 512 : (pn == 12) ? 768 : 1024;
#pragma unroll
                    for (int bj = 0; bj < 2; ++bj) store8(proj + (size_t)r * NPJ + off + 128 * bj + 32 * wc + 8 * fq, v[bj][0], v[bj][1]);
                }
                asm volatile("" ::: "memory"); __builtin_amdgcn_sched_barrier(0);
            }
    }
};
struct EpiRes {
    static constexpr bool PERM = true, AFTER_DRAIN = true;
    const float* xold; float* xnew; unsigned char* ws;
    __device__ __forceinline__ void operator()(const f32x4 (&)[2][2][4][2], const Unit&, int, int, int, int) const {}
    __device__ __forceinline__ void fused(f32x4 (&acc)[2][2][4][2], const Unit& u, int wr, int wc, int fr, int fq, PG8_LAS unsigned char* lds, int wid, int lane) const {
        bf16_t* xbf = (bf16_t*)(ws + WS_XBF); float* ssx = (float*)(ws + WS_SSX);
        PG8_LAS float* P = (PG8_LAS float*)lds;
#pragma unroll
        for (int ai = 0; ai < 2; ++ai)
#pragma unroll
            for (int m = 0; m < 4; ++m) {
                const int rl = ai * 128 + wr * 64 + m * 16 + fr, r = u.pm * 256 + rl; float q = 0.f;
#pragma unroll
                for (int bj = 0; bj < 2; ++bj) { const size_t off = (size_t)r * DM + u.pn * 256 + 128 * bj + 32 * wc + 8 * fq;
                    const f32x4 o0 = *(const f32x4*)(xold + off) + acc[ai][bj][m][0], o1 = *(const f32x4*)(xold + off + 4) + acc[ai][bj][m][1];
                    *(f32x4*)(xnew + off) = o0; *(f32x4*)(xnew + off + 4) = o1; store8(xbf + off, o0, o1); q += sq4(o0) + sq4(o1); }
                q += __shfl_xor(q, 16); q += __shfl_xor(q, 32);
                if (fq == 0) P[rl * 4 + wc] = q;
                if (m & 1) { asm volatile("" ::: "memory"); __builtin_amdgcn_sched_barrier(0); }
            }
        asm volatile("s_waitcnt lgkmcnt(0)" ::: "memory"); __builtin_amdgcn_s_barrier(); asm volatile("" ::: "memory");
        const int t = wid * 64 + lane;
        if (t < 256) { const f32x4 pv = *(const PG8_LAS f32x4*)(P + t * 4); ssx[(size_t)(u.pm * 256 + t) * 4 + u.pn] = sum4(pv); }
        asm volatile("s_waitcnt lgkmcnt(0)" ::: "memory"); __builtin_amdgcn_s_barrier(); asm volatile("" ::: "memory");
    }
};
struct EpiResFinal {
    static constexpr bool PERM = true, AFTER_DRAIN = true;
    const float* xold; float* out; const float* gain; float* slots  ; unsigned* cnt  ;
    __device__ __forceinline__ void operator()(const f32x4 (&)[2][2][4][2], const Unit&, int, int, int, int) const {}
    __device__ __forceinline__ void fused(f32x4 (&acc)[2][2][4][2], const Unit& u, int wr, int wc, int fr, int fq, PG8_LAS unsigned char* lds, int wid, int lane) const {
        PG8_LAS float* P = (PG8_LAS float*)lds;
        PG8_LAS float* Sr = (PG8_LAS float*)(lds + 4096);
#pragma unroll
        for (int ai = 0; ai < 2; ++ai)
#pragma unroll
            for (int m = 0; m < 4; ++m) {
                const int rl = ai * 128 + wr * 64 + m * 16 + fr, r = u.pm * 256 + rl; float q = 0.f;
#pragma unroll
                for (int bj = 0; bj < 2; ++bj) { const size_t off = (size_t)r * DM + u.pn * 256 + 128 * bj + 32 * wc + 8 * fq;
                    acc[ai][bj][m][0] += *(const f32x4*)(xold + off); acc[ai][bj][m][1] += *(const f32x4*)(xold + off + 4); q += sq4(acc[ai][bj][m][0]) + sq4(acc[ai][bj][m][1]); }
                q += __shfl_xor(q, 16); q += __shfl_xor(q, 32);
                if (fq == 0) P[rl * 4 + wc] = q;
                if (m & 1) { asm volatile("" ::: "memory"); __builtin_amdgcn_sched_barrier(0); }
            }
        asm volatile("s_waitcnt lgkmcnt(0)" ::: "memory"); __builtin_amdgcn_s_barrier(); asm volatile("" ::: "memory");
        const int t = wid * 64 + lane;
        if (t < 256) { const f32x4 pv = *(const PG8_LAS f32x4*)(P + t * 4); __hip_atomic_store(slots + (size_t)(u.pm * 256 + t) * 4 + u.pn, sum4(pv), __ATOMIC_RELAXED, __HIP_MEMORY_SCOPE_AGENT); }
        asm volatile("s_waitcnt vmcnt(0)" ::: "memory");
        __builtin_amdgcn_s_barrier(); asm volatile("" ::: "memory");
        if (t == 0) {
            __hip_atomic_fetch_add(cnt + 64 * u.pm, 1u, __ATOMIC_RELAXED, __HIP_MEMORY_SCOPE_AGENT);
            unsigned sp = 0u;
            while (__hip_atomic_load(cnt + 64 * u.pm, __ATOMIC_RELAXED, __HIP_MEMORY_SCOPE_AGENT) < 4u) { __builtin_amdgcn_s_sleep(2); if (++sp > (1u << 22)) break; }
            __builtin_amdgcn_fence(__ATOMIC_ACQUIRE, "agent");
        }
        asm volatile("s_waitcnt vmcnt(0) lgkmcnt(0)" ::: "memory"); __builtin_amdgcn_s_barrier(); asm volatile("" ::: "memory");
        if (t < 256) { const float* sl = slots + (size_t)(u.pm * 256 + t) * 4; float s = 0.f;
#pragma unroll
            for (int k = 0; k < 4; ++k) s += __hip_atomic_load(sl + k, __ATOMIC_RELAXED, __HIP_MEMORY_SCOPE_AGENT);
            Sr[t] = __builtin_amdgcn_rsqf(s * (1.f / 1024.f) + EPS); }
        asm volatile("s_waitcnt vmcnt(0) lgkmcnt(0)" ::: "memory"); __builtin_amdgcn_s_barrier(); asm volatile("" ::: "memory");
#pragma unroll
        for (int ai = 0; ai < 2; ++ai)
#pragma unroll
            for (int m = 0; m < 4; ++m) {
                const int rl = ai * 128 + wr * 64 + m * 16 + fr, r = u.pm * 256 + rl; const float rs = Sr[rl];
#pragma unroll
                for (int bj = 0; bj < 2; ++bj) { const int col = u.pn * 256 + 128 * bj + 32 * wc + 8 * fq; const size_t off = (size_t)r * DM + col;
                    *(f32x4*)(out + off) = acc[ai][bj][m][0] * rs * *(const f32x4*)(gain + col); *(f32x4*)(out + off + 4) = acc[ai][bj][m][1] * rs * *(const f32x4*)(gain + col + 4); }
            }
    }
};
struct EpiSwi {
    static constexpr bool PERM = true, AFTER_DRAIN = false;
    unsigned char* ws;
    __device__ __forceinline__ void operator()(const f32x4 (&acc)[2][2][4][2], const Unit& u, int wr, int wc, int fr_, int fq_) const {
        int fr = fr_, fq = fq_; asm volatile("" : "+v"(fr), "+v"(fq));
        const float* ssx = (const float*)(ws + WS_SSX); bf16_t* act = (bf16_t*)(ws + WS_ACT);
        float rs8[2][4]; load_rstd8(ssx, u.pm * 256 + wr * 64 + fr, rs8);
#pragma unroll
        for (int ai = 0; ai < 2; ++ai)
#pragma unroll
            for (int m = 0; m < 4; ++m) {
                const int r = u.pm * 256 + ai * 128 + wr * 64 + m * 16 + fr;
                const float rs = rs8[ai][m];
                f32x4 o[2];
#pragma unroll
                for (int n = 0; n < 2; ++n) { const f32x4 g = acc[ai][0][m][n] * rs, up = acc[ai][1][m][n] * rs;
#pragma unroll
                    for (int i = 0; i < 4; ++i) o[n][i] = g[i] * __builtin_amdgcn_rcpf(1.f + __expf(-g[i])) * up[i]; }
                store8(act + (size_t)r * FF + u.pn * 128 + 32 * wc + 8 * fq, o[0], o[1]);
                __builtin_amdgcn_sched_barrier(0);
            }
    }
};

__device__ __forceinline__ int sigperm(int p) { return p < 16 ? (((p >> 2) & 1) * 8 + ((p >> 3) & 1) * 4 + (p & 3)) : p; }
struct MapIn { const float* win; const float* wfq; const float* wfkv;
    __device__ __forceinline__ void operator()(int n, const float*& src, int& ld, int& col) const {
        const int t = n >> 8, c = n & 255; src = win; ld = INW; col = 0;
        switch (t) {
            case 0: col = c; break;
            case 1: if (c < 128) col = 256 + c; else if (c < 160) col = 384 + (c - 128); else if (c < 176) col = 928 + (c - 160); else src = nullptr; break;
            case 2: src = wfq; ld = 384; col = (c >> 6) * 96 + (c & 63); break;
            case 3: if (c < 128) { src = wfq; ld = 384; col = (c >> 5) * 96 + 64 + (c & 31); } else col = 416 + (c - 128); break;
            case 4: src = wfkv; ld = 512; col = (c >> 6) * 128 + (c & 63); break;
            case 5: src = wfkv; ld = 512; col = (c >> 6) * 128 + 64 + (c & 63); break;
            case 6: if (c < 128) col = 544 + c; else src = nullptr; break;
            case 7: col = 672 + c; break;
            case 8: col = 944 + c; break;
            case 9: col = 1200 + (c & ~63) + sigperm(c & 63); break;
            case 10: col = 1456 + (c & ~63) + sigperm(c & 63); break;
            case 11: col = 1712 + c; break;
            case 12: col = 1968 + c; break;
            default: col = 2224 + c; break;
        }
    }
};
struct MapPlain { const float* w; int N;
    __device__ __forceinline__ void operator()(int n, const float*& src, int& ld, int& col) const { src = w; ld = N; col = n; } };
struct MapFfnIn { const float* w;
    __device__ __forceinline__ void operator()(int n, const float*& src, int& ld, int& col) const { const int t = n >> 8, c = n & 255; src = w; ld = NFI; col = (c < 128) ? (128 * t + c) : (FF + 128 * t + (c - 128)); } };
template <class Map> __device__ __forceinline__ void transpose_item(const Map& mp, int K, int nblk, bf16_t* WT, const float* gain, LAS float* scr, int item, int lane) {
    const int kb = item / nblk, nb = item % nblk, k0 = 64 * kb, n0 = 32 * nb;
    const float* src; int ld, col; mp(n0 + (lane & 31), src, ld, col);
    float vv[32];
#pragma unroll
    for (int i = 0; i < 32; ++i) { const int kk = 2 * i + (lane >> 5); vv[i] = src ? src[(size_t)(k0 + kk) * ld + col] : 0.f; }
#pragma unroll
    for (int i = 0; i < 32; ++i) { const int kk = 2 * i + (lane >> 5); float v = vv[i]; if (gain) v *= gain[k0 + kk]; scr[kk * 33 + (lane & 31)] = v; }
    asm volatile("s_waitcnt lgkmcnt(0)" ::: "memory");
    const int c = lane & 7;
#pragma unroll
    for (int j = 0; j < 4; ++j) { const int n = (lane >> 3) + 8 * j; const LAS float* s = scr + (8 * c) * 33 + n;
        u32x4 o; o.x = pk2(s[0 * 33], s[1 * 33]); o.y = pk2(s[2 * 33], s[3 * 33]); o.z = pk2(s[4 * 33], s[5 * 33]); o.w = pk2(s[6 * 33], s[7 * 33]);
        *(u32x4*)(WT + (size_t)(n0 + n) * K + k0 + 8 * c) = o; }
    asm volatile("s_waitcnt lgkmcnt(0)" ::: "memory");
}
__device__ __forceinline__ void convert_ffn_weights(const Params& p, int l, LAS unsigned char* lds, int gwave, int gwaves, int wave, int lane) {
    LAS float* scr = (LAS float*)(lds + wave * 16384);
    unsigned char* ws = WSP();
    constexpr int I_FI = (DM / 64) * (NFI / 32), I_FO = (FF / 64) * (DM / 32);
    const MapFfnIn mfi{INP(I_W_FFN_IN) + (size_t)l * DM * NFI}; const MapPlain mfo{INP(I_W_FFN_OUT) + (size_t)l * FF * DM, DM};
    for (int it = gwave; it < I_FI + I_FO; it += gwaves) {
        if (it < I_FI) transpose_item(mfi, DM, NFI / 32, (bf16_t*)(ws + WS_WFI), INP(I_FFN_NORM) + l * DM, scr, it, lane);
        else transpose_item(mfo, FF, DM / 32, (bf16_t*)(ws + WS_WFO), nullptr, scr, it - I_FI, lane);
    }
}
__device__ __forceinline__ void fuse_weights(LAS unsigned char* lds, int tid) {
    unsigned char* ws = WSP(); LAS float* As = (LAS float*)lds; LAS float* Bs = As + 64 * 33;
    for (int it = blockIdx.x; it < 448; it += gridDim.x) {
        const int l = it / 224, r_ = it - l * 224; const bool isq = r_ < 96; const int tt = isq ? r_ : r_ - 96, nj = isq ? 6 : 8, kt = tt / nj, jt = tt - kt * nj;
        const int R = isq ? 256 : 128, NU = isq ? 384 : 512, roff = isq ? 0 : 256;
        const float* win = INP(I_W_IN) + (size_t)l * DM * INW + (size_t)(kt * 64) * INW + roff;
        const float* g = isq ? INP(I_Q_NORM) + l * 256 : INP(I_KV_NORM) + l * 128;
        const float* wu = (isq ? INP(I_W_UQ) + (size_t)l * 256 * 384 : INP(I_W_UKV) + (size_t)l * 128 * 512) + jt * 64;
        float* o = (isq ? (float*)(ws + WS_WFQ) + (size_t)l * DM * 384 : (float*)(ws + WS_WFKV) + (size_t)l * DM * 512) + (size_t)(kt * 64) * NU + jt * 64;
        const int ty = tid >> 4, tx = tid & 15; float acc[2][4];
#pragma unroll
        for (int x = 0; x < 2; ++x)
#pragma unroll
            for (int y = 0; y < 4; ++y) acc[x][y] = 0.f;
        for (int r0 = 0; r0 < R; r0 += 32) {
            __syncthreads();
#pragma unroll
            for (int i = 0; i < 4; ++i) { const int e = tid + 512 * i, kk = e >> 5, rr = e & 31; As[kk * 33 + rr] = win[(size_t)kk * INW + r0 + rr] * g[r0 + rr]; }
#pragma unroll
            for (int i = 0; i < 4; ++i) { const int e = tid + 512 * i, rr = e >> 6, jj = e & 63; Bs[rr * 64 + jj] = wu[(size_t)(r0 + rr) * NU + jj]; }
            __syncthreads();
#pragma unroll 8
            for (int rr = 0; rr < 32; ++rr) { const float a0 = As[(2 * ty) * 33 + rr], a1 = As[(2 * ty + 1) * 33 + rr]; const f32x4 bv = *(const LAS f32x4*)(Bs + rr * 64 + 4 * tx);
#pragma unroll
                for (int y = 0; y < 4; ++y) { acc[0][y] += a0 * bv[y]; acc[1][y] += a1 * bv[y]; } }
        }
#pragma unroll
        for (int x = 0; x < 2; ++x) *(f32x4*)(o + (size_t)(2 * ty + x) * NU + 4 * tx) = (f32x4){acc[x][0], acc[x][1], acc[x][2], acc[x][3]};
    }
    __syncthreads();
}
__device__ __forceinline__ void prologue_a(const Params& p, int gtid, int gthreads, int gwave, int gwaves, int lane) {
    unsigned char* ws = WSP();
    { const float* x = INP(I_X); bf16_t* xbf = (bf16_t*)(ws + WS_XBF); float* ssx = (float*)(ws + WS_SSX);
      for (int r2 = gwave; r2 < T / 2; r2 += gwaves) { f32x4 v[2][4];
#pragma unroll
          for (int u = 0; u < 2; ++u) { const f32x4* xr = (const f32x4*)(x + (size_t)(2 * r2 + u) * DM) + lane;
#pragma unroll
              for (int j = 0; j < 4; ++j) v[u][j] = xr[64 * j]; }
#pragma unroll
          for (int u = 0; u < 2; ++u) { const int r = 2 * r2 + u; float s = 0.f;
#pragma unroll
              for (int j = 0; j < 4; ++j) s += sq4(v[u][j]);
              s = wave_sum(s);
              unsigned long long* o8 = (unsigned long long*)(xbf + (size_t)r * DM) + lane;
#pragma unroll
              for (int j = 0; j < 4; ++j) o8[64 * j] = (unsigned long long)pk2(v[u][j][0], v[u][j][1]) | ((unsigned long long)pk2(v[u][j][2], v[u][j][3]) << 32);
              if (lane < 4) ssx[(size_t)r * 4 + lane] = (lane == 0) ? s : 0.f; } } }
    { float* ra = (float*)(ws + WS_ROPEA); float* rm = (float*)(ws + WS_ROPEM);
      for (int idx = gtid; idx < S * 24; idx += gthreads) { const int s = idx / 24, j = idx - s * 24; const double f = (j < 16) ? exp(-13.122363377404328 * (double)(2 * j) / 32.0) : exp(-13.122363377404328 * (double)(2 * (j - 16)) / 16.0);
          double rv = (double)s * f * 0.15915494309189535; rv -= floor(rv); const float fr = (float)rv;
          const float c = __builtin_amdgcn_cosf(fr), sn = __builtin_amdgcn_sinf(fr);
          if (j < 16) { ra[s * 16 + j] = c; ra[S * 16 + s * 16 + j] = sn; } else { rm[s * 8 + (j - 16)] = c; rm[S * 8 + s * 8 + (j - 16)] = sn; } } }
}
__device__ __forceinline__ void prologue_b(const Params& p, LAS unsigned char* lds, int gwave, int gwaves, int wave, int lane) {
    LAS float* scr = (LAS float*)(lds + wave * 16384);
    unsigned char* ws = WSP();
    constexpr int I_IN = (DM / 64) * (NIN / 32), I_OUT = (DM / 64) * (DM / 32);
    for (int it = gwave; it < 2 * (I_IN + I_OUT); it += gwaves) {
        const int l = it / (I_IN + I_OUT), r = it - l * (I_IN + I_OUT);
        if (r < I_IN) { const MapIn mi{INP(I_W_IN) + (size_t)l * DM * INW, (const float*)(ws + WS_WFQ) + (size_t)l * DM * 384, (const float*)(ws + WS_WFKV) + (size_t)l * DM * 512};
            transpose_item(mi, DM, NIN / 32, (bf16_t*)(ws + WS_WIN) + (size_t)l * NIN * DM, INP(I_ATTN_NORM) + l * DM, scr, r, lane); }
        else { const MapPlain mo{INP(I_W_OUT) + (size_t)l * DM * DM, DM};
            transpose_item(mo, DM, DM / 32, (bf16_t*)(ws + WS_WOUT) + (size_t)l * DM * DM, nullptr, scr, r - I_IN, lane); }
    }
    convert_ffn_weights(p, 0, lds, gwave, gwaves, wave, lane);
}

typedef float f32x16 __attribute__((ext_vector_type(16)));
using pg8::bf16x8;
#define ZERO16(v) do { _Pragma("unroll") for (int i_ = 0; i_ < 16; ++i_) v[i_] = 0.f; } while (0)

__device__ __forceinline__ void mid_mla(const Params& p, int gtid, int gthreads) {
    unsigned char* ws = WSP();
    bf16_t* Qa = (bf16_t*)(ws + WS_QA); bf16_t* Ka = (bf16_t*)(ws + WS_KA); bf16_t* Vta = (bf16_t*)(ws + WS_VTA);
    const float* ssq = (const float*)(ws + WS_SSQ); const float* ssk = (const float*)(ws + WS_SSK); const float* kpga = (const float*)(ws + WS_KPGA);
    const float* rc = (const float*)(ws + WS_ROPEA); const float* rsn = rc + S * 16;
    for (int idx = gtid; idx < T * 4; idx += gthreads) {
        const int b = idx / (4 * S), s = idx & (S - 1), r = b * S + s;
        const float rq = __builtin_amdgcn_rsqf(sum4(*(const f32x4*)(ssq + (size_t)r * 4)) * (1.f / 256.f) + EPS) * C_MLA;
        const float rk = __builtin_amdgcn_rsqf(sum4(*(const f32x4*)(ssk + (size_t)r * 4)) * (1.f / 128.f) + EPS);
        u32x4* q = (u32x4*)(Qa + (size_t)idx * 96); u32x4* k = (u32x4*)(Ka + ka_off(idx >> 12, s, 0));
        u32x4 qv[8], kv[8];
#pragma unroll
        for (int c = 0; c < 8; ++c) { qv[c] = q[c]; kv[c] = k[32 * c]; }
#pragma unroll
        for (int c = 0; c < 8; ++c) { u32x4 w = qv[c];
            w.x = pk2(bflo(w.x) * rq, bfhi(w.x) * rq); w.y = pk2(bflo(w.y) * rq, bfhi(w.y) * rq); w.z = pk2(bflo(w.z) * rq, bfhi(w.z) * rq); w.w = pk2(bflo(w.w) * rq, bfhi(w.w) * rq); q[c] = w;
            u32x4 z = kv[c];
            z.x = pk2(bflo(z.x) * rk, bfhi(z.x) * rk); z.y = pk2(bflo(z.y) * rk, bfhi(z.y) * rk); z.z = pk2(bflo(z.z) * rk, bfhi(z.z) * rk); z.w = pk2(bflo(z.w) * rk, bfhi(z.w) * rk); k[32 * c] = z; }
#pragma unroll
        for (int c = 0; c < 2; ++c) {
            const u32x4 a = q[8 + c], bq = q[10 + c];
            const f32x4 c0 = *(const f32x4*)(rc + s * 16 + 8 * c), c1 = *(const f32x4*)(rc + s * 16 + 8 * c + 4), s0 = *(const f32x4*)(rsn + s * 16 + 8 * c), s1 = *(const f32x4*)(rsn + s * 16 + 8 * c + 4);
            const float x1[8] = {bflo(a.x), bfhi(a.x), bflo(a.y), bfhi(a.y), bflo(a.z), bfhi(a.z), bflo(a.w), bfhi(a.w)};
            const float x2[8] = {bflo(bq.x), bfhi(bq.x), bflo(bq.y), bfhi(bq.y), bflo(bq.z), bfhi(bq.z), bflo(bq.w), bfhi(bq.w)};
            const float cc[8] = {c0[0], c0[1], c0[2], c0[3], c1[0], c1[1], c1[2], c1[3]}; const float ss[8] = {s0[0], s0[1], s0[2], s0[3], s1[0], s1[1], s1[2], s1[3]};
            float o1[8], o2[8];
#pragma unroll
            for (int i = 0; i < 8; ++i) { o1[i] = (x1[i] * cc[i] - x2[i] * ss[i]) * rq; o2[i] = (x2[i] * cc[i] + x1[i] * ss[i]) * rq; }
            u32x4 w1, w2; w1.x = pk2(o1[0], o1[1]); w1.y = pk2(o1[2], o1[3]); w1.z = pk2(o1[4], o1[5]); w1.w = pk2(o1[6], o1[7]);
            w2.x = pk2(o2[0], o2[1]); w2.y = pk2(o2[2], o2[3]); w2.z = pk2(o2[4], o2[5]); w2.w = pk2(o2[6], o2[7]);
            q[8 + c] = w1; q[10 + c] = w2;
            const f32x4 ka = *(const f32x4*)(kpga + (size_t)r * 48 + 8 * c), kb = *(const f32x4*)(kpga + (size_t)r * 48 + 8 * c + 4), kc = *(const f32x4*)(kpga + (size_t)r * 48 + 16 + 8 * c), kd = *(const f32x4*)(kpga + (size_t)r * 48 + 16 + 8 * c + 4);
            const float y1[8] = {ka[0], ka[1], ka[2], ka[3], kb[0], kb[1], kb[2], kb[3]}; const float y2[8] = {kc[0], kc[1], kc[2], kc[3], kd[0], kd[1], kd[2], kd[3]};
            float e1[8], e2[8];
#pragma unroll
            for (int i = 0; i < 8; ++i) { e1[i] = y1[i] * cc[i] - y2[i] * ss[i]; e2[i] = y2[i] * cc[i] + y1[i] * ss[i]; }
            u32x4 v1, v2; v1.x = pk2(e1[0], e1[1]); v1.y = pk2(e1[2], e1[3]); v1.z = pk2(e1[4], e1[5]); v1.w = pk2(e1[6], e1[7]);
            v2.x = pk2(e2[0], e2[1]); v2.y = pk2(e2[2], e2[3]); v2.z = pk2(e2[4], e2[5]); v2.w = pk2(e2[6], e2[7]);
            k[32 * (8 + c)] = v1; k[32 * (10 + c)] = v2;
        }
    }
    for (int ci = gtid; ci < 16 * S * 8; ci += gthreads) {
        const int bh = ci >> 15, rem = ci & 32767, tile = rem >> 8, i256 = (rem >> 5) & 7, s16 = (i256 >> 1) & 1, hh = i256 & 1;
        const int tok = (bh >> 2) * S + tile * 32 + 16 * s16 + 4 * hh;
        float rk[8];
#pragma unroll
        for (int i = 0; i < 8; ++i) rk[i] = __builtin_amdgcn_rsqf(sum4(*(const f32x4*)(ssk + (size_t)(tok + 8 * (i >> 2) + (i & 3)) * 4)) * (1.f / 128.f) + EPS);
        u32x4* vp = (u32x4*)(Vta + (size_t)ci * 8); u32x4 w = *vp;
        w.x = pk2(bflo(w.x) * rk[0], bfhi(w.x) * rk[1]); w.y = pk2(bflo(w.y) * rk[2], bfhi(w.y) * rk[3]); w.z = pk2(bflo(w.z) * rk[4], bfhi(w.z) * rk[5]); w.w = pk2(bflo(w.w) * rk[6], bfhi(w.w) * rk[7]);
        *vp = w;
    }
}
__device__ __forceinline__ void mid_kmean(const Params& p, LAS unsigned char* lds, int tid) {
    const bf16_t* Km = (const bf16_t*)(WSP() + WS_KM); float* kmean = (float*)(WSP() + WS_KMEAN); LAS float* red = (LAS float*)lds;
    for (int it = blockIdx.x; it < 256; it += gridDim.x) {
        const int d = tid & 63, part = tid >> 6; const bf16_t* base = Km + km_off(it >> 4, (it & 15) * 256 + part * 32, d); float s = 0.f;
        for (int k = 0; k < 32; ++k) s += bf2f(base[k * 8]);
        red[part * 64 + d] = s; __syncthreads();
        if (tid < 64) { float t = 0.f;
#pragma unroll
            for (int q = 0; q < 8; ++q) t += red[q * 64 + tid];
            kmean[it * 64 + tid] = t * (1.f / 256.f); }
        __syncthreads();
    }
}
struct GlaLds { LAS float *alow, *sk, *sv, *sb; };
constexpr int GLA_HS = 16000;
__device__ __forceinline__ void gla_common(const Params& p, int l, int item, const GlaLds& L, int t) {
    const int h = item & 3, bn = item >> 2, r0 = bn * 64;
    const bf16_t* proj = (const bf16_t*)(WSP() + WS_PROJ); const float* kpga = (const float*)(WSP() + WS_KPGA);
    const float* wa2 = INP(I_GLA_WA2) + l * 16 * 128; const float* ba2 = INP(I_GLA_BA2) + l * 128;
    { const int tt = t >> 2, j4 = (t & 3) * 4; *(LAS f32x4*)(L.alow + tt * 16 + j4) = *(const f32x4*)(kpga + (size_t)(r0 + tt) * 48 + 32 + j4); }
    { const int tt = t >> 2, d8 = (t & 3) * 8; const u32x4 w = *(const u32x4*)(proj + (size_t)(r0 + tt) * NPJ + 128 + h * 32 + d8); LAS float* d = L.sk + tt * 33 + d8;
      d[0] = bflo(w.x); d[1] = bfhi(w.x); d[2] = bflo(w.y); d[3] = bfhi(w.y); d[4] = bflo(w.z); d[5] = bfhi(w.z); d[6] = bflo(w.w); d[7] = bfhi(w.w); }
#pragma unroll
    for (int i = 0; i < 2; ++i) { const int c = t + 256 * i, tt = c >> 3, d8 = (c & 7) * 8; const u32x4 w = *(const u32x4*)(proj + (size_t)(r0 + tt) * NPJ + 256 + h * 64 + d8); LAS float* d = L.sv + tt * 64 + d8;
      *(LAS f32x4*)d = (f32x4){bflo(w.x), bfhi(w.x), bflo(w.y), bfhi(w.y)}; *(LAS f32x4*)(d + 4) = (f32x4){bflo(w.z), bfhi(w.z), bflo(w.w), bfhi(w.w)}; }
    __syncthreads();
    for (int i = t; i < 64 * 32; i += 256) { const int tt = i >> 5, d = i & 31; float z = ba2[h * 32 + d];
#pragma unroll
        for (int j = 0; j < 16; ++j) z += L.alow[tt * 16 + j] * wa2[j * 128 + h * 32 + d];
        L.sb[tt * 33 + d] = logsigmoidf_(z) * (1.f / 16.f); }
    __syncthreads();
    { const int d = t & 31, sg = t >> 5;
      float v[8]; float c = 0.f;
#pragma unroll
      for (int k = 0; k < 8; ++k) { c += L.sb[(8 * sg + k) * 33 + d]; v[k] = c; }
      L.alow[sg * 32 + d] = c;
      __syncthreads();
      float off = 0.f;
      for (int s2 = 0; s2 < sg; ++s2) off += L.alow[s2 * 32 + d];
#pragma unroll
      for (int k = 0; k < 8; ++k) L.sb[(8 * sg + k) * 33 + d] = v[k] + off; }
    __syncthreads();
}
__device__ __forceinline__ float* sb_cache() { return (float*)(WSP() + WS_WFQ); }
__device__ __forceinline__ void gla_common_cached(int item, const GlaLds& L, int t) {
    const int h = item & 3, bn = item >> 2, r0 = bn * 64;
    const bf16_t* proj = (const bf16_t*)(WSP() + WS_PROJ); const float* sbc = sb_cache();
    { const int tt = t >> 2, d8 = (t & 3) * 8; const u32x4 w = *(const u32x4*)(proj + (size_t)(r0 + tt) * NPJ + 128 + h * 32 + d8); LAS float* d = L.sk + tt * 33 + d8;
      const f32x4 b0 = *(const f32x4*)(sbc + (size_t)(r0 + tt) * 128 + h * 32 + d8), b1 = *(const f32x4*)(sbc + (size_t)(r0 + tt) * 128 + h * 32 + d8 + 4); LAS float* e = L.sb + tt * 33 + d8;
      d[0] = bflo(w.x); d[1] = bfhi(w.x); d[2] = bflo(w.y); d[3] = bfhi(w.y); d[4] = bflo(w.z); d[5] = bfhi(w.z); d[6] = bflo(w.w); d[7] = bfhi(w.w);
      e[0] = b0[0]; e[1] = b0[1]; e[2] = b0[2]; e[3] = b0[3]; e[4] = b1[0]; e[5] = b1[1]; e[6] = b1[2]; e[7] = b1[3]; }
#pragma unroll
    for (int i = 0; i < 2; ++i) { const int c = t + 256 * i, tt = c >> 3, d8 = (c & 7) * 8; const u32x4 w = *(const u32x4*)(proj + (size_t)(r0 + tt) * NPJ + 256 + h * 64 + d8); LAS float* d = L.sv + tt * 64 + d8;
      *(LAS f32x4*)d = (f32x4){bflo(w.x), bfhi(w.x), bflo(w.y), bfhi(w.y)}; *(LAS f32x4*)(d + 4) = (f32x4){bflo(w.z), bfhi(w.z), bflo(w.w), bfhi(w.w)}; }
    __syncthreads();
}
__device__ __forceinline__ void mid_gla(const Params& p, int l, LAS unsigned char* lds, int tid) {
    const int hb = tid >> 8, t = tid & 255;
    LAS float* f = (LAS float*)lds + hb * GLA_HS; const GlaLds L{f, f + 1024, f + 1024 + 64 * 33, f + 1024 + 64 * 33 + 4096};
    float* gds = (float*)(WSP() + WS_GDS); float* gdec = (float*)(WSP() + WS_GDEC); float* sbc = sb_cache();
    for (int it2 = blockIdx.x; it2 < 512; it2 += gridDim.x) {
        const int item = it2 * 2 + hb;
        gla_common(p, l, item, L, t);
        const int h = item & 3, bn = item >> 2, b = bn >> 6, n = bn & 63, bh = b * 4 + h, r0 = bn * 64;
        { const int tt = t >> 2, d8 = (t & 3) * 8; float bv[8], bl[8];
#pragma unroll
          for (int e = 0; e < 8; ++e) { bv[e] = L.sb[tt * 33 + d8 + e]; bl[e] = L.sb[63 * 33 + d8 + e]; }
          *(f32x4*)(sbc + (size_t)(r0 + tt) * 128 + h * 32 + d8) = (f32x4){bv[0], bv[1], bv[2], bv[3]}; *(f32x4*)(sbc + (size_t)(r0 + tt) * 128 + h * 32 + d8 + 4) = (f32x4){bv[4], bv[5], bv[6], bv[7]};
#pragma unroll
          for (int e = 0; e < 8; ++e) L.sk[tt * 33 + d8 + e] *= __expf(bl[e] - bv[e]); }
        __syncthreads();
        { const int lane = tid & 63, wv = (tid >> 6) & 3, r = lane & 31, hf = lane >> 5;
          if (wv < 2) { const int v0 = 32 * wv; f32x16 D; ZERO16(D);
#pragma unroll
              for (int ks = 0; ks < 4; ++ks) { float fa[8], fb[8];
#pragma unroll
                  for (int e = 0; e < 8; ++e) { const int tt = 16 * ks + 8 * hf + e; fa[e] = L.sk[tt * 33 + r]; fb[e] = L.sv[tt * 64 + v0 + r]; }
                  u32x4 wa, wb; wa.x = cvt_pk_safe(fa[0], fa[1]); wa.y = cvt_pk_safe(fa[2], fa[3]); wa.z = cvt_pk_safe(fa[4], fa[5]); wa.w = cvt_pk_safe(fa[6], fa[7]);
                  wb.x = cvt_pk_safe(fb[0], fb[1]); wb.y = cvt_pk_safe(fb[2], fb[3]); wb.z = cvt_pk_safe(fb[4], fb[5]); wb.w = cvt_pk_safe(fb[6], fb[7]);
                  D = __builtin_amdgcn_mfma_f32_32x32x16_bf16(__builtin_bit_cast(bf16x8, wa), __builtin_bit_cast(bf16x8, wb), D, 0, 0, 0); }
              float* o = gds + (size_t)(bh * 64 + n) * 2048 + v0 + r;
#pragma unroll
              for (int i = 0; i < 16; ++i) o[((i & 3) + 8 * (i >> 2) + 4 * hf) * 64] = D[i]; } }
        if (t < 32) gdec[(bh * 64 + n) * 32 + t] = __expf(L.sb[63 * 33 + t]);
        __syncthreads();
    }
}
__device__ __forceinline__ float neg_expm1(float x) {
    if (x > -0.25f) { float q = 1.f / 720.f; q = q * x + 1.f / 120.f; q = q * x + 1.f / 24.f; q = q * x + 1.f / 6.f; q = q * x + 0.5f; q = q * x + 1.f; return -x * q; }
    return 1.f - __expf(x);
}
__device__ __forceinline__ void mid_lru(const Params& p, int l, LAS unsigned char* lds, int tid) {
    LAS float* sx = (LAS float*)lds; LAS float* sxc = sx + 35 * 256;
    const bf16_t* proj = (const bf16_t*)(WSP() + WS_PROJ);
    float* lra = (float*)(WSP() + WS_LRA); float* lru = (float*)(WSP() + WS_LRU); float* aggA = (float*)(WSP() + WS_AGGA); float* aggU = (float*)(WSP() + WS_AGGU);
    const float* cw = INP(I_CONV_W) + l * 4 * 256; const float* cb = INP(I_CONV_B) + l * 256;
    const float* wa = INP(I_LRU_WA) + l * 4 * 64 * 64; const float* wx = INP(I_LRU_WX) + l * 4 * 64 * 64;
    const float* ba = INP(I_LRU_BA) + l * 256; const float* bx = INP(I_LRU_BX) + l * 256; const float* lam = INP(I_LRU_LAM) + l * 256;
    for (int item = blockIdx.x; item < T / 32; item += gridDim.x) {
        const int r0 = item * 32, s0 = r0 & (S - 1);
        for (int i = tid; i < 35 * 32; i += 512) { const int t = i >> 5, c8 = (i & 31) * 8; const int sp = s0 + t - 3;
            u32x4 w = (u32x4){0u, 0u, 0u, 0u}; if (sp >= 0) w = *(const u32x4*)(proj + (size_t)(r0 + t - 3) * NPJ + 768 + c8);
            LAS float* d = sx + t * 256 + c8; d[0] = bflo(w.x); d[1] = bfhi(w.x); d[2] = bflo(w.y); d[3] = bfhi(w.y); d[4] = bflo(w.z); d[5] = bfhi(w.z); d[6] = bflo(w.w); d[7] = bfhi(w.w); }
        __syncthreads();
        for (int i = tid; i < 32 * 256; i += 512) { const int t = i >> 8, ch = i & 255; float a = cb[ch];
#pragma unroll
            for (int j = 0; j < 4; ++j) a += cw[j * 256 + ch] * sx[(t + j) * 256 + ch];
            sxc[i] = a; }
        __syncthreads();
        const int ch = tid & 255, half = tid >> 8, n = ch >> 6, d = ch & 63;
        f32x2 acc2[16];
#pragma unroll
        for (int t = 0; t < 16; ++t) acc2[t] = (f32x2){0.f, 0.f};
#pragma unroll 2
        for (int c0 = 0; c0 < 64; c0 += 8) { f32x2 w2[8];
#pragma unroll
            for (int cc = 0; cc < 8; ++cc) { w2[cc][0] = wa[(n * 64 + c0 + cc) * 64 + d]; w2[cc][1] = wx[(n * 64 + c0 + cc) * 64 + d]; }
#pragma unroll
            for (int t = 0; t < 16; ++t) { const f32x4 x0 = *(const LAS f32x4*)(sxc + (half * 16 + t) * 256 + n * 64 + c0), x1 = *(const LAS f32x4*)(sxc + (half * 16 + t) * 256 + n * 64 + c0 + 4);
#pragma unroll
                for (int cc = 0; cc < 4; ++cc) { acc2[t] += (f32x2){x0[cc], x0[cc]} * w2[cc]; acc2[t] += (f32x2){x1[cc], x1[cc]} * w2[4 + cc]; } } }
        float ar[16], ai[16];
#pragma unroll
        for (int t = 0; t < 16; ++t) { ar[t] = acc2[t][0]; ai[t] = acc2[t][1]; }
        const float lm = lam[ch], sp = fmaxf(-lm, 0.f) + __logf(1.f + __expf(-fabsf(lm)));
        const float b1 = ba[ch], b2 = bx[ch];
        float A = 1.f, U = 0.f;
#pragma unroll
        for (int t = 0; t < 16; ++t) {
            const float rr = sigmoidf_(ar[t] + b1), ig = sigmoidf_(ai[t] + b2);
            const float la = -8.f * rr * sp, a = __expf(la), mult = __builtin_amdgcn_sqrtf(neg_expm1(2.f * la));
            const float u = mult * ig * sxc[(half * 16 + t) * 256 + ch];
            const size_t o = (size_t)(r0 + half * 16 + t) * 256 + ch; lra[o] = a; lru[o] = u;
            A *= a; U = a * U + u;
        }
        const int b = r0 >> 12, c16 = (s0 >> 4) + half;
        aggA[((size_t)(b * 256 + ch)) * 256 + c16] = A; aggU[((size_t)(b * 256 + ch)) * 256 + c16] = U;
        __syncthreads();
    }
}

__device__ __forceinline__ void seq_scans(const Params& p, LAS unsigned char* lds, int tid, int gwave, int gwaves, int lane) {
    { float* gds = (float*)(WSP() + WS_GDS); const float* gdec = (const float*)(WSP() + WS_GDEC); LAS float* ex = (LAS float*)lds;
      for (int blk = blockIdx.x; blk < 256; blk += gridDim.x) {
          const int el = tid & 127, seg = tid >> 7, idx = blk * 128 + el, bh = idx >> 11, e = idx & 2047, dk = e >> 6;
          float* base = gds + (size_t)bh * 64 * 2048 + (size_t)(seg * 16) * 2048 + e; const float* dc = gdec + (bh * 64 + seg * 16) * 32 + dk;
          float ds[16], dd[16];
#pragma unroll
          for (int j = 0; j < 16; ++j) { ds[j] = base[(size_t)j * 2048]; dd[j] = dc[j * 32]; }
          float A = 1.f, U = 0.f;
#pragma unroll
          for (int j = 0; j < 16; ++j) { U = dd[j] * U + ds[j]; A *= dd[j]; }
          ex[(seg * 128 + el) * 2] = A; ex[(seg * 128 + el) * 2 + 1] = U;
          __syncthreads();
          float st = 0.f;
          for (int s2 = 0; s2 < seg; ++s2) st = ex[(s2 * 128 + el) * 2] * st + ex[(s2 * 128 + el) * 2 + 1];
#pragma unroll
          for (int j = 0; j < 16; ++j) { base[(size_t)j * 2048] = st; st = dd[j] * st + ds[j]; }
          __syncthreads();
      } }
    { const float* aggA = (const float*)(WSP() + WS_AGGA); const float* aggU = (const float*)(WSP() + WS_AGGU); float* carry = (float*)(WSP() + WS_CARRY);
      for (int it = gwave; it < 1024; it += gwaves) {
          const f32x4 a = *(const f32x4*)(aggA + (size_t)it * 256 + 4 * lane), u = *(const f32x4*)(aggU + (size_t)it * 256 + 4 * lane);
          float At = a[0], Ut = u[0];
#pragma unroll
          for (int k = 1; k < 4; ++k) { Ut = a[k] * Ut + u[k]; At = At * a[k]; }
#pragma unroll
          for (int off = 1; off < 64; off <<= 1) { const float Ao = __shfl_up(At, off), Uo = __shfl_up(Ut, off); if (lane >= off) { Ut = At * Uo + Ut; At = Ao * At; } }
          float hin = __shfl_up(Ut, 1); if (lane == 0) hin = 0.f;
          f32x4 c; c[0] = hin; c[1] = a[0] * c[0] + u[0]; c[2] = a[1] * c[1] + u[1]; c[3] = a[2] * c[2] + u[2];
          *(f32x4*)(carry + (size_t)it * 256 + 4 * lane) = c; } }
}
__device__ __forceinline__ size_t ka_off(int bh, int s, int d) { return (size_t)bh * S * 96 + (size_t)(s >> 5) * 3072 + (d >> 3) * 256 + (s & 31) * 8 + (d & 7); }
__device__ __forceinline__ size_t km_off(int bh, int s, int d) { return (size_t)bh * S * 64 + (size_t)(s >> 5) * 2048 + (d >> 3) * 256 + (s & 31) * 8 + (d & 7); }
__device__ __forceinline__ size_t vf_off(int bh, int key, int dv) { return (size_t)bh * S * 64 + (size_t)(key >> 5) * 2048 + ((((dv >> 5) * 2 + ((key >> 4) & 1)) * 2 + ((key >> 2) & 1)) * 256) + (dv & 31) * 8 + ((key >> 3) & 1) * 4 + (key & 3); }
template <int NKS> __device__ __forceinline__ void attn_load(const bf16_t* Kb, const bf16_t* Vb, int kt, int lane, bf16x8 (&kf)[NKS], bf16x8 (&vf)[4]) {
    const bf16_t* kp = Kb + (size_t)kt * (512 * NKS) + lane * 8; const bf16_t* vp = Vb + (size_t)kt * 2048 + lane * 8;
#pragma unroll
    for (int ks = 0; ks < NKS; ++ks) kf[ks] = *(const bf16x8*)(kp + ks * 512);
#pragma unroll
    for (int i = 0; i < 4; ++i) vf[i] = *(const bf16x8*)(vp + i * 512);
}
__device__ __forceinline__ float max3f_nop(float a, float b, float c) { float r; asm volatile("s_nop 15\n\ts_nop 3\n\tv_max3_f32 %0, %1, %2, %3" : "=v"(r) : "v"(a), "v"(b), "v"(c)); return r; }
__device__ __forceinline__ float max3f_(float a, float b, float c) { float r; asm volatile("v_max3_f32 %0, %1, %2, %3" : "=v"(r) : "v"(a), "v"(b), "v"(c)); return r; }
__device__ __forceinline__ float max2f_(float a, float b) { float r; asm volatile("v_max_f32_e32 %0, %1, %2" : "=v"(r) : "v"(a), "v"(b)); return r; }
template <int NKS> __device__ __forceinline__ void attn_tile(const bf16x8 (&kf)[NKS], const bf16x8 (&vf)[4], const bf16x8 (&qf)[NKS], bool diag, bool act, int r, int h, f32x16& O0, f32x16& O1, float& m, float& l) {
    f32x16 X;
#pragma unroll
    for (int i = 0; i < 16; ++i) X[i] = 0.f;
#pragma unroll
    for (int ks = 0; ks < NKS; ++ks) X = __builtin_amdgcn_mfma_f32_32x32x16_bf16(kf[ks], qf[ks], X, 0, 0, 0);
    if (diag) {
#pragma unroll
        for (int i = 0; i < 16; ++i) if ((i & 3) + 8 * (i >> 2) + 4 * h > r) X[i] = NEG_INF;
    }
    if (__ballot(!act) != 0ull) {
#pragma unroll
        for (int i = 0; i < 16; ++i) X[i] = act ? X[i] : NEG_INF;
    }
    float mx;
    { const float t0 = max3f_nop(X[0], X[1], X[2]), t1 = max3f_(X[3], X[4], X[5]), t2 = max3f_(X[6], X[7], X[8]), t3 = max3f_(X[9], X[10], X[11]), t4 = max3f_(X[12], X[13], X[14]);
      mx = max2f_(max3f_(t0, t1, X[15]), max3f_(t2, t3, t4)); }
    { const u32x2 pr = __builtin_amdgcn_permlane32_swap(__float_as_uint(mx), __float_as_uint(mx), false, false);
      mx = max2f_(__uint_as_float(pr[0]), __uint_as_float(pr[1])); }
    const float m_old = m; const float mn = max2f_(m, mx), ms = (mn == NEG_INF) ? 0.f : mn, al = __builtin_amdgcn_exp2f(m - ms); m = mn;
    f32x2 s2[4];
#pragma unroll
    for (int i = 0; i < 8; ++i) { const f32x2 d = (f32x2){X[2 * i], X[2 * i + 1]} - (f32x2){ms, ms}; X[2 * i] = __builtin_amdgcn_exp2f(d[0]); X[2 * i + 1] = __builtin_amdgcn_exp2f(d[1]); }
#pragma unroll
    for (int i = 0; i < 4; ++i) s2[i] = (f32x2){X[4 * i], X[4 * i + 1]} + (f32x2){X[4 * i + 2], X[4 * i + 3]};
    const f32x2 s1 = (s2[0] + s2[1]) + (s2[2] + s2[3]);
    const float ps = s1[0] + s1[1];
    l = l * al + ps;
    if (__ballot(mn != m_old) != 0ull) {
#pragma unroll
        for (int i = 0; i < 16; ++i) { O0[i] *= al; O1[i] *= al; }
    }
    bf16x8 p0, p1;
    { u32x4 w; w.x = cvt_pk_bf16(X[0], X[1]); w.y = cvt_pk_bf16(X[2], X[3]); w.z = cvt_pk_bf16(X[4], X[5]); w.w = cvt_pk_bf16(X[6], X[7]); p0 = __builtin_bit_cast(bf16x8, w);
      w.x = cvt_pk_bf16(X[8], X[9]); w.y = cvt_pk_bf16(X[10], X[11]); w.z = cvt_pk_bf16(X[12], X[13]); w.w = cvt_pk_bf16(X[14], X[15]); p1 = __builtin_bit_cast(bf16x8, w); }
    O0 = __builtin_amdgcn_mfma_f32_32x32x16_bf16(vf[0], p0, O0, 0, 0, 0);
    O0 = __builtin_amdgcn_mfma_f32_32x32x16_bf16(vf[1], p1, O0, 0, 0, 0);
    O1 = __builtin_amdgcn_mfma_f32_32x32x16_bf16(vf[2], p0, O1, 0, 0, 0);
    O1 = __builtin_amdgcn_mfma_f32_32x32x16_bf16(vf[3], p1, O1, 0, 0, 0);
}
__device__ __forceinline__ void attn_store(bf16_t* yrow, int h, const f32x16& O0, const f32x16& O1, float l) {
    const float inv = __builtin_amdgcn_rcpf(l + __shfl_xor(l, 32));
#pragma unroll
    for (int g = 0; g < 4; ++g) { u32x2 w; w.x = cvt_pk_bf16(O0[4 * g] * inv, O0[4 * g + 1] * inv); w.y = cvt_pk_bf16(O0[4 * g + 2] * inv, O0[4 * g + 3] * inv); *(u32x2*)(yrow + 8 * g + 4 * h) = w;
        u32x2 z; z.x = cvt_pk_bf16(O1[4 * g] * inv, O1[4 * g + 1] * inv); z.y = cvt_pk_bf16(O1[4 * g + 2] * inv, O1[4 * g + 3] * inv); *(u32x2*)(yrow + 32 + 8 * g + 4 * h) = z; }
}
__device__ __forceinline__ unsigned moba_select(const float* kmean_bh, const bf16x8 (&qf)[4], int blk, int h) {
    const float* kmean = kmean_bh + 8 * h;
    float g0 = NEG_INF, g1 = NEG_INF, g2 = NEG_INF; int i0 = -1, i1 = -1, i2 = -1;
    for (int jb = 0; jb < blk; ++jb) { float a = 0.f;
#pragma unroll
        for (int ks = 0; ks < 4; ++ks) { const f32x4 w0 = *(const f32x4*)(kmean + jb * 64 + 16 * ks), w1 = *(const f32x4*)(kmean + jb * 64 + 16 * ks + 4); const u32x4 qw = __builtin_bit_cast(u32x4, qf[ks]);
            a += bflo(qw.x) * w0[0] + bfhi(qw.x) * w0[1] + bflo(qw.y) * w0[2] + bfhi(qw.y) * w0[3] + bflo(qw.z) * w1[0] + bfhi(qw.z) * w1[1] + bflo(qw.w) * w1[2] + bfhi(qw.w) * w1[3]; }
        a += __shfl_xor(a, 32);
        if (a > g0) { g2 = g1; i2 = i1; g1 = g0; i1 = i0; g0 = a; i0 = jb; } else if (a > g1) { g2 = g1; i2 = i1; g1 = a; i1 = jb; } else if (a > g2) { g2 = a; i2 = jb; } }
    unsigned sel = 0u; if (i0 >= 0) sel |= 1u << i0; if (i1 >= 0) sel |= 1u << i1; if (i2 >= 0) sel |= 1u << i2;
    return sel;
}
template <int NKS, bool MOBA> __device__ __forceinline__ void attn_block(int bh, int qi, LAS unsigned char* lds, int tid, int wave, int lane) {
    unsigned char* ws = WSP(); const int r = lane & 31, h = lane >> 5, b = bh >> 2, hh = bh & 3, qt = 8 * qi + wave, q = qt * 32 + r;
    constexpr int DK = 16 * NKS, KCH = 64 * NKS  , TOT = KCH + 256;
    const bf16_t* Qp = (const bf16_t*)(ws + (MOBA ? WS_QM : WS_QA)) + ((size_t)bh * S + q) * DK + 8 * h;
    bf16x8 qf[NKS];
#pragma unroll
    for (int ks = 0; ks < NKS; ++ks) qf[ks] = *(const bf16x8*)(Qp + 16 * ks);
    unsigned sel = 0u;
    if (MOBA) sel = moba_select((const float*)(ws + WS_KMEAN) + (size_t)bh * 16 * 64, (const bf16x8 (&)[4])qf, qi, h);
    const bf16_t* Kb = (const bf16_t*)(ws + (MOBA ? WS_KM : WS_KA)) + (size_t)bh * S * DK; const bf16_t* Vb = (const bf16_t*)(ws + (MOBA ? WS_VTM : WS_VTA)) + (size_t)bh * S * 64;
    f32x16 O0, O1; ZERO16(O0); ZERO16(O1);
    float m = NEG_INF, l = 0.f;
    const int kt1 = 8 * qi + 8;
    const bool two = (tid + 512) < TOT;
    const int c0 = tid, c1 = two ? tid + 512 : tid + 512 - 256;
    const size_t off0 = (c0 < KCH) ? (size_t)c0 * 8 : (size_t)(c0 - KCH) * 8, off1 = (size_t)(c1 - KCH) * 8;
    const bf16_t* src0 = (c0 < KCH) ? Kb : Vb; const size_t tstep0 = (c0 < KCH) ? (size_t)(8 * KCH) : (size_t)2048;
    u32x4 g0, g1;
#define ATT_GLOAD(kt_) do { const int kc_ = ((kt_) < kt1) ? (kt_) : kt1 - 1; g0 = *(const u32x4*)(src0 + (size_t)kc_ * tstep0 + off0); g1 = *(const u32x4*)(Vb + (size_t)kc_ * 2048 + off1); } while (0)
#define ATT_LSTORE(buf_) do { *(LAS u32x4*)(lds + (buf_) * 16384 + c0 * 16) = g0; if (two) *(LAS u32x4*)(lds + (buf_) * 16384 + c1 * 16) = g1; } while (0)
    constexpr int NPFK = KCH / 8, NPF = NPFK + 32;
    unsigned pA = 0u, pB = 0u, pC = 0u, pD = 0u;
    const int pfl = tid % NPF; const char* pfsrc = (pfl < NPFK) ? (const char*)Kb + pfl * 128 : (const char*)Vb + (pfl - NPFK) * 128; const size_t pfstep = (pfl < NPFK) ? (size_t)(16 * KCH) : (size_t)4096;
#define ATT_PF(kt_, reg_) do { const int kc_ = ((kt_) < kt1) ? (kt_) : kt1 - 1; reg_ = *(const unsigned*)(pfsrc + (size_t)kc_ * pfstep); } while (0)
#define ATT_BAR() asm volatile("s_waitcnt lgkmcnt(0)\n\ts_barrier" ::: "memory")
#define ATT_STEP(kt_, reg_) do { const int kt = (kt_); const int cur = kt & 1; \
        asm volatile("" :: "v"(reg_)); \
        ATT_GLOAD(kt + 1); \
        ATT_PF(kt + 4, reg_); \
        bool act = true; \
        if (MOBA) { const int jb = kt >> 3; act = (jb == qi) || ((sel >> jb) & 1u); } \
        if (kt <= qt && __ballot(act) != 0ull) { \
            bf16x8 kf[NKS], vf[4]; const LAS unsigned char* base = lds + cur * 16384 + lane * 16; \
            _Pragma("unroll") for (int ks = 0; ks < NKS; ++ks) kf[ks] = *(const LAS bf16x8*)(base + ks * 1024); \
            _Pragma("unroll") for (int i = 0; i < 4; ++i) vf[i] = *(const LAS bf16x8*)(base + KCH * 16 + i * 1024); \
            attn_tile<NKS>(kf, vf, qf, kt == qt, act, r, h, O0, O1, m, l); \
        } \
        ATT_LSTORE(cur ^ 1); \
        ATT_BAR(); } while (0)
    __syncthreads();
    ATT_GLOAD(0); ATT_PF(1, pB); ATT_PF(2, pC); ATT_PF(3, pD); ATT_LSTORE(0);
    ATT_BAR();
    for (int kt4 = 0; kt4 < kt1; kt4 += 4) {
        ATT_STEP(kt4, pA); ATT_STEP(kt4 + 1, pB); ATT_STEP(kt4 + 2, pC); ATT_STEP(kt4 + 3, pD);
    }
    asm volatile("" :: "v"(pA), "v"(pB), "v"(pC), "v"(pD));
#undef ATT_PF
#undef ATT_BAR
#undef ATT_STEP
#undef ATT_GLOAD
#undef ATT_LSTORE
    attn_store((bf16_t*)(ws + WS_YCAT) + (size_t)(b * S + q) * DM + (MOBA ? 512 : 0) + hh * 64, h, O0, O1, l);
}

__device__ __forceinline__ void post_gla(const Params& p, int l, LAS unsigned char* lds, int tid) {
    const int hb = tid >> 8, t = tid & 255;
    LAS float* f = (LAS float*)lds + hb * GLA_HS; const GlaLds L{f, f + 1024, f + 1024 + 64 * 33, f + 1024 + 64 * 33 + 4096};
    LAS float* sqe = f + 1024 + 2 * 64 * 33 + 4096; LAS float* sqb = sqe + 64 * 33; LAS float* sst = sqb + 64 * 33; LAS float* srs = sst + 2048;
    const bf16_t* proj = (const bf16_t*)(WSP() + WS_PROJ); const float* gds = (const float*)(WSP() + WS_GDS); bf16_t* ycat = (bf16_t*)(WSP() + WS_YCAT);
    const float* hn = INP(I_GLA_HN) + l * 64;
    for (int it2 = blockIdx.x; it2 < 512; it2 += gridDim.x) {
        const int item = it2 * 2 + hb;
        gla_common_cached(item, L, t);
        const int h = item & 3, bn = item >> 2, b = bn >> 6, n = bn & 63, bh = b * 4 + h, r0 = bn * 64;
        { const int tt = t >> 2, d8 = (t & 3) * 8; const u32x4 w = *(const u32x4*)(proj + (size_t)(r0 + tt) * NPJ + h * 32 + d8);
          const float qv[8] = {bflo(w.x), bfhi(w.x), bflo(w.y), bfhi(w.y), bflo(w.z), bfhi(w.z), bflo(w.w), bfhi(w.w)};
#pragma unroll
          for (int e = 0; e < 8; ++e) { const int d = d8 + e; const float bb = L.sb[tt * 33 + d], br = 0.5f * L.sb[63 * 33 + d], q1 = qv[e] * 0.17677669529663687f;
              sqe[tt * 33 + d] = q1 * __expf(bb - br); sqb[tt * 33 + d] = q1 * __expf(bb); L.sk[tt * 33 + d] *= __expf(br - bb); } }
#pragma unroll
        for (int i = 0; i < 2; ++i) { const int c = t + 256 * i; *(LAS f32x4*)(sst + c * 4) = *(const f32x4*)(gds + (size_t)(bh * 64 + n) * 2048 + c * 4); }
        __syncthreads();
        f32x16 O; ZERO16(O);
        const int lane = tid & 63, wv = (tid >> 6) & 3, r = lane & 31, hf = lane >> 5, it = (wv >> 1) & 1, vt = wv & 1, i0 = 32 * it, v0 = 32 * vt;
        if (wv < 4) {
#define FRAG_ROW(dst, arr, rowstride, row, col0) do { float f_[8]; _Pragma("unroll") for (int e_ = 0; e_ < 8; ++e_) f_[e_] = arr[(row) * (rowstride) + (col0) + e_]; \
            u32x4 w_; w_.x = cvt_pk_safe(f_[0], f_[1]); w_.y = cvt_pk_safe(f_[2], f_[3]); w_.z = cvt_pk_safe(f_[4], f_[5]); w_.w = cvt_pk_safe(f_[6], f_[7]); dst = __builtin_bit_cast(bf16x8, w_); } while (0)
#define FRAG_COL(dst, arr, colstride, k0_, col) do { float f_[8]; _Pragma("unroll") for (int e_ = 0; e_ < 8; ++e_) f_[e_] = arr[((k0_) + 8 * (e_ >> 2) + (e_ & 3)) * (colstride) + (col)]; \
            u32x4 w_; w_.x = cvt_pk_safe(f_[0], f_[1]); w_.y = cvt_pk_safe(f_[2], f_[3]); w_.z = cvt_pk_safe(f_[4], f_[5]); w_.w = cvt_pk_safe(f_[6], f_[7]); dst = __builtin_bit_cast(bf16x8, w_); } while (0)
#pragma unroll
            for (int ks = 0; ks < 2; ++ks) { bf16x8 fa, fb; float f_[8];
#pragma unroll
                for (int e_ = 0; e_ < 8; ++e_) f_[e_] = sst[(16 * ks + 8 * hf + e_) * 64 + v0 + r];
                { u32x4 w_; w_.x = cvt_pk_safe(f_[0], f_[1]); w_.y = cvt_pk_safe(f_[2], f_[3]); w_.z = cvt_pk_safe(f_[4], f_[5]); w_.w = cvt_pk_safe(f_[6], f_[7]); fa = __builtin_bit_cast(bf16x8, w_); }
                FRAG_ROW(fb, sqb, 33, i0 + r, 16 * ks + 8 * hf);
                O = __builtin_amdgcn_mfma_f32_32x32x16_bf16(fa, fb, O, 0, 0, 0); }
            for (int jt = 0; jt <= it; ++jt) {
                f32x16 X; ZERO16(X);
#pragma unroll
                for (int ks = 0; ks < 2; ++ks) { bf16x8 fa, fb; FRAG_ROW(fa, L.sk, 33, 32 * jt + r, 16 * ks + 8 * hf); FRAG_ROW(fb, sqe, 33, i0 + r, 16 * ks + 8 * hf);
                    X = __builtin_amdgcn_mfma_f32_32x32x16_bf16(fa, fb, X, 0, 0, 0); }
                if (jt == it) {
#pragma unroll
                    for (int i = 0; i < 16; ++i) if ((i & 3) + 8 * (i >> 2) + 4 * hf > r) X[i] = 0.f;
                }
                bf16x8 p0, p1;
                { u32x4 w; w.x = cvt_pk_safe(X[0], X[1]); w.y = cvt_pk_safe(X[2], X[3]); w.z = cvt_pk_safe(X[4], X[5]); w.w = cvt_pk_safe(X[6], X[7]); p0 = __builtin_bit_cast(bf16x8, w);
                  w.x = cvt_pk_safe(X[8], X[9]); w.y = cvt_pk_safe(X[10], X[11]); w.z = cvt_pk_safe(X[12], X[13]); w.w = cvt_pk_safe(X[14], X[15]); p1 = __builtin_bit_cast(bf16x8, w); }
                bf16x8 va, vb; FRAG_COL(va, L.sv, 64, 32 * jt + 4 * hf, v0 + r); FRAG_COL(vb, L.sv, 64, 32 * jt + 16 + 4 * hf, v0 + r);
                O = __builtin_amdgcn_mfma_f32_32x32x16_bf16(va, p0, O, 0, 0, 0);
                O = __builtin_amdgcn_mfma_f32_32x32x16_bf16(vb, p1, O, 0, 0, 0);
            }
#undef FRAG_ROW
#undef FRAG_COL
            float ss = 0.f;
#pragma unroll
            for (int i = 0; i < 16; ++i) ss += O[i] * O[i];
            ss += __shfl_xor(ss, 32);
            if (hf == 0) srs[(it * 2 + vt) * 32 + r] = ss;
        }
        __syncthreads();
        if (wv < 4) {
            const float rs = __builtin_amdgcn_rsqf((srs[(it * 2) * 32 + r] + srs[(it * 2 + 1) * 32 + r]) * (1.f / 64.f) + EPS);
            const int row = r0 + i0 + r;
#pragma unroll
            for (int g4 = 0; g4 < 4; ++g4) { const int v = v0 + 8 * g4 + 4 * hf;
                const u32x2 gw = *(const u32x2*)(proj + (size_t)row * NPJ + 512 + h * 64 + v); const float g[4] = {bflo(gw.x), bfhi(gw.x), bflo(gw.y), bfhi(gw.y)};
                const f32x4 gn = *(const f32x4*)(hn + v); float y[4];
#pragma unroll
                for (int c = 0; c < 4; ++c) y[c] = O[4 * g4 + c] * rs * gn[c] * (g[c] * __builtin_amdgcn_rcpf(1.f + __expf(-g[c])));
                u32x2 w; w.x = cvt_pk_safe(y[0], y[1]); w.y = cvt_pk_safe(y[2], y[3]); *(u32x2*)(ycat + (size_t)row * DM + 256 + h * 64 + v) = w; }
        }
        __syncthreads();
    }
}
__device__ __forceinline__ void post_lru(const Params& p, int gtid, int gthreads) {
    const float* lra = (const float*)(WSP() + WS_LRA); const float* lru = (const float*)(WSP() + WS_LRU); const float* carry = (const float*)(WSP() + WS_CARRY);
    const bf16_t* proj = (const bf16_t*)(WSP() + WS_PROJ); bf16_t* ycat = (bf16_t*)(WSP() + WS_YCAT);
    for (int idx = gtid; idx < 4 * 256 * 256; idx += gthreads) {
        const int ch = idx & 255, c16 = (idx >> 8) & 255, b = idx >> 16; float hcur = carry[(size_t)(b * 256 + ch) * 256 + c16];
        const int r0 = b * S + c16 * 16;
        float av[16], uv[16], gv[16];
#pragma unroll
        for (int t = 0; t < 16; ++t) { const size_t o = (size_t)(r0 + t) * 256 + ch; av[t] = lra[o]; uv[t] = lru[o]; gv[t] = bf2f(proj[(size_t)(r0 + t) * NPJ + 1024 + ch]); }
#pragma unroll
        for (int t = 0; t < 16; ++t) { hcur = av[t] * hcur + uv[t]; ycat[(size_t)(r0 + t) * DM + 768 + ch] = (bf16_t)f2bf(hcur * gelu_tanh(gv[t])); }
    }
}
__device__ __forceinline__ void final_norm(const Params& p, int gwave, int gwaves, int lane) {
    float* out = OUTP(); const float* g = INP(I_FINAL_NORM);
    f32x4 gv[4];
#pragma unroll
    for (int j = 0; j < 4; ++j) gv[j] = ((const f32x4*)g)[64 * j + lane];
    for (int r2 = gwave; r2 < T / 2; r2 += gwaves) { f32x4 v[2][4];
#pragma unroll
        for (int u = 0; u < 2; ++u) { const f32x4* xr = (const f32x4*)(out + (size_t)(2 * r2 + u) * DM) + lane;
#pragma unroll
            for (int j = 0; j < 4; ++j) v[u][j] = xr[64 * j]; }
#pragma unroll
        for (int u = 0; u < 2; ++u) { f32x4* xr = (f32x4*)(out + (size_t)(2 * r2 + u) * DM) + lane; float s = 0.f;
#pragma unroll
            for (int j = 0; j < 4; ++j) s += sq4(v[u][j]);
            const float rs = __builtin_amdgcn_rsqf(wave_sum(s) * (1.f / 1024.f) + EPS);
#pragma unroll
            for (int j = 0; j < 4; ++j) xr[64 * j] = v[u][j] * rs * gv[j]; } }
}
#define TIDS int tid = threadIdx.x; asm volatile("" : "+v"(tid)); const int lane = tid & 63, wave = __builtin_amdgcn_readfirstlane(tid >> 6); \
    const int G = gridDim.x, gtid = blockIdx.x * 512 + tid, gthreads = G * 512, gwave = blockIdx.x * 8 + wave, gwaves = G * 8; (void)lane; (void)gtid; (void)gthreads; (void)gwave; (void)gwaves;
#ifdef DUP_SYNC
#define GSYNC() do { xcd_barrier(xbar); xcd_barrier(xbar); } while (0)
#else
#define GSYNC() xcd_barrier(xbar)
#endif
template <int l> __device__ __forceinline__ void layer_body(const Params& p, LAS unsigned char* lds, const XcdBarrier& xbar) {
#ifndef NO_P1
        { unsigned char* ws = WSP(); pg8::Gemm g{(const bf16_t*)(ws + WS_XBF), (const bf16_t*)(ws + WS_WIN) + (size_t)l * NIN * DM, T, NIN, DM}; pg8::StaticOrder so; so.init(T, NIN, (int)gridDim.x, (int)blockIdx.x);
          EpiIn E{ws};
          pg8::gemm_phase<EpiIn, pg8::StaticOrder, true, true>(lds, g, so, E);
#ifdef DUP_P1
          __syncthreads(); pg8::gemm_phase<EpiIn, pg8::StaticOrder, true, true>(lds, g, so, E);
#endif
        }
#endif
        GSYNC();
#ifndef NO_MID
        { TIDS; mid_mla(p, gtid, gthreads); mid_kmean(p, lds, tid); mid_gla(p, l, lds, tid); mid_lru(p, l, lds, tid); }
#ifdef DUP_MIDG
        { TIDS; mid_gla(p, l, lds, tid); }
#endif
#ifdef DUP_MIDL
        { TIDS; mid_lru(p, l, lds, tid); }
#endif
#endif
        if (l == 1) { TIDS; convert_ffn_weights(p, 1, lds, gwave, gwaves, wave, lane); }
        GSYNC();
        { TIDS; seq_scans(p, lds, tid, gwave, gwaves, lane);
          asm volatile("s_waitcnt vmcnt(0)" ::: "memory"); __syncthreads();
          if (tid == 0) { __builtin_amdgcn_fence(__ATOMIC_RELEASE, "agent"); asm volatile("s_waitcnt vmcnt(0)" ::: "memory");
                          __hip_atomic_fetch_add((unsigned*)(WSP() + WS_LRW + 36864) + 64 * l, 1u, __ATOMIC_RELAXED, __HIP_MEMORY_SCOPE_AGENT); }
#ifndef NO_ATT
          { const int x = blockIdx.x & 7, j = blockIdx.x >> 3, bh = 2 * x + (j & 1), qi = j >> 1;
            attn_block<6, false>(bh, qi, lds, tid, wave, lane); attn_block<4, true>(bh, 15 - qi, lds, tid, wave, lane);
#ifdef DUP_ATT
            attn_block<6, false>(bh, qi, lds, tid, wave, lane); attn_block<4, true>(bh, 15 - qi, lds, tid, wave, lane);
#endif
          }
#endif
          if (tid == 0) { unsigned sp = 0u; while (__hip_atomic_load((unsigned*)(WSP() + WS_LRW + 36864) + 64 * l, __ATOMIC_RELAXED, __HIP_MEMORY_SCOPE_AGENT) < gridDim.x) { __builtin_amdgcn_s_sleep(2); if (++sp > (1u << 22)) break; }
                          __builtin_amdgcn_fence(__ATOMIC_ACQUIRE, "agent"); asm volatile("s_waitcnt vmcnt(0)" ::: "memory"); }
          __syncthreads();
        }
#ifndef NO_POST
        { TIDS; post_gla(p, l, lds, tid); post_lru(p, gtid, gthreads); }
#ifdef DUP_POST
        { TIDS; post_gla(p, l, lds, tid); post_lru(p, gtid, gthreads); }
#endif
#endif
        GSYNC();
#ifndef NO_P5
        { unsigned char* ws = WSP(); pg8::Gemm g{(const bf16_t*)(ws + WS_YCAT), (const bf16_t*)(ws + WS_WOUT) + (size_t)l * DM * DM, T, DM, DM}; pg8::StaticOrder so; so.init(T, DM, (int)gridDim.x, (int)blockIdx.x);
          EpiRes E{(l == 0) ? INP(I_X) : (const float*)OUTP(), OUTP(), ws};
          pg8::gemm_phase<EpiRes, pg8::StaticOrder, true, true>(lds, g, so, E); }
#endif
        GSYNC();
#ifndef NO_P6
        { unsigned char* ws = WSP(); pg8::Gemm g{(const bf16_t*)(ws + WS_XBF), (const bf16_t*)(ws + WS_WFI), T, NFI, DM}; pg8::StaticOrder so; so.init(T, NFI, (int)gridDim.x, (int)blockIdx.x);
          EpiSwi E{ws};
          pg8::gemm_phase<EpiSwi, pg8::StaticOrder, true, true>(lds, g, so, E);
#ifdef DUP_P6
          __syncthreads(); pg8::gemm_phase<EpiSwi, pg8::StaticOrder, true, true>(lds, g, so, E);
#endif
        }
#endif
        GSYNC();
#ifndef NO_P7
        { unsigned char* ws = WSP(); pg8::Gemm g{(const bf16_t*)(ws + WS_ACT), (const bf16_t*)(ws + WS_WFO), T, DM, FF}; pg8::StaticOrder so; so.init(T, DM, (int)gridDim.x, (int)blockIdx.x);
          if (l == 1) { EpiResFinal E{(const float*)OUTP(), OUTP(), INP(I_FINAL_NORM), (float*)(ws + WS_SSX), (unsigned*)(ws + WS_LRW + 16384)};
                        pg8::gemm_phase<EpiResFinal, pg8::StaticOrder, true, true>(lds, g, so, E); }
          else { EpiRes E{(const float*)OUTP(), OUTP(), ws};
                 pg8::gemm_phase<EpiRes, pg8::StaticOrder, true, true>(lds, g, so, E); } }
#endif
        if (l == 0) GSYNC();
    }
__global__ void __launch_bounds__(512) mega_fwd(Params p) {
    extern __shared__ __attribute__((aligned(16))) unsigned char lds_raw[];
    LAS unsigned char* lds = (LAS unsigned char*)lds_raw;
    cg::grid_group grid = cg::this_grid();
    (void)p;
    if (threadIdx.x < 4) ((volatile LAS unsigned*)(lds + 131072))[threadIdx.x] = 0u;
    __syncthreads();
    const XcdBarrier xbar = xcd_barrier_post((unsigned*)(WSP() + WS_LRW), (volatile LAS unsigned*)(lds + 131072));
    { TIDS; fuse_weights(lds, tid); }
    { TIDS; prologue_a(p, gtid, gthreads, gwave, gwaves, lane); }
    if (gridDim.x == 0x7fffffffu) grid.sync();
    GSYNC();
    { TIDS; prologue_b(p, lds, gwave, gwaves, wave, lane); }
    GSYNC();
#ifdef DUP_PRO
    { TIDS; prologue_a(p, gtid, gthreads, gwave, gwaves, lane); }
    GSYNC();
    { TIDS; prologue_b(p, lds, gwave, gwaves, wave, lane); }
    GSYNC();
#endif
    layer_body<0>(p, lds, xbar);
    layer_body<1>(p, lds, xbar);
}
}

extern "C" void kernel_launch(void* const* d_in, const int* in_sizes, int n_in, void* d_out, int out_size, void* d_ws, size_t ws_size, hipStream_t stream) {
    static int grid = 0;
    if (grid == 0) {
        if (n_in != 22 || ws_size < mk::WS_END) { fprintf(stderr, "kernel_launch: unexpected inputs (n_in %d, ws %zu)\n", n_in, ws_size); grid = -1; return; }
        int dev = 0, cus = 0, per_cu = 0;
        hipGetDevice(&dev); hipDeviceGetAttribute(&cus, hipDeviceAttributeMultiprocessorCount, dev);
        if (hipFuncSetAttribute((const void*)mk::mega_fwd, hipFuncAttributeMaxDynamicSharedMemorySize, mk::LDS_BYTES) != hipSuccess) { fprintf(stderr, "kernel_launch: hipFuncSetAttribute failed\n"); grid = -1; return; }
        if (hipOccupancyMaxActiveBlocksPerMultiprocessor(&per_cu, (const void*)mk::mega_fwd, 512, mk::LDS_BYTES) != hipSuccess || per_cu < 1) per_cu = 1;
        (void)hipGetLastError();
        grid = cus * per_cu;
        if (grid != 256) { fprintf(stderr, "kernel_launch: this kernel needs a 256-workgroup grid (got %d)\n", grid); grid = -1; return; }
    }
    if (grid < 0) return;
    mk::Params p{};
    for (int i = 0; i < 22; ++i) p.in[i] = (const float*)d_in[i];
    p.out = (float*)d_out; p.ws = (unsigned char*)d_ws;
    if (hipMemsetAsync((char*)d_ws + mk::WS_LRW, 0, 49152, stream) != hipSuccess) { fprintf(stderr, "kernel_launch: memset of the barrier words failed\n"); return; }
    void* args[] = {&p};
    hipError_t e = hipLaunchCooperativeKernel((const void*)mk::mega_fwd, dim3(grid), dim3(512), args, mk::LDS_BYTES, stream);
    if (e != hipSuccess) fprintf(stderr, "cooperative launch failed: %s (grid %d)\n", hipGetErrorString(e), grid);
}
```
